# Optimizing an MI355X kernel written in HIP

```python
import jax, jax.numpy as jnp
from jax import lax
import numpy as np

D_MODEL = 1024
BATCH = 8
SEQ = 4096
DEPTH = 4

N_MIXERS = 3
ROPE_THETA = 10000.0
NORM_EPS = 1e-6
NEG_INF = -1e30
ATTN_BLOCK = 128
D_FF = 4 * D_MODEL

MLA_HEADS = 16
MLA_Q_RANK = 384
MLA_KV_RANK = 256
MLA_NOPE_DIM = 64
MLA_ROPE_DIM = 32
MLA_V_DIM = 64

FOX_HEADS = 16
FOX_HEAD_DIM = 64
FORGET_BIAS_CENTER = 2.0

DIL_PATTERNS = ((128, 1), (512, 4), (2048, 16))
DIL_GROUPS = len(DIL_PATTERNS)
DIL_HEADS = 16
DIL_HEAD_DIM = 64
DIL_KEYS = max(w // d for w, d in DIL_PATTERNS) + 1
DIL_BLOCK = 32

kernel_name = "hybrid_mla_fox_dilated_interleaved"


def rmsnorm(x, g):
    xf = x.astype(jnp.float32)
    y = xf * lax.rsqrt(jnp.mean(xf * xf, axis=-1, keepdims=True) + NORM_EPS)
    return (y * g.astype(jnp.float32)).astype(x.dtype)


def rope_tables(seq_len, dim):
    inv = 1.0 / (ROPE_THETA ** (jnp.arange(0, dim, 2, dtype=jnp.float32) / dim))
    ang = jnp.arange(seq_len, dtype=jnp.float32)[:, None] * inv[None, :]
    return jnp.cos(ang), jnp.sin(ang)


def apply_rope(x, cos, sin):
    half = x.shape[-1] // 2
    x1 = x[..., :half].astype(jnp.float32)
    x2 = x[..., half:].astype(jnp.float32)
    c = cos[None, :, None, :]
    s = sin[None, :, None, :]
    return jnp.concatenate([x1 * c - x2 * s, x1 * s + x2 * c], axis=-1).astype(x.dtype)


def causal_block_attention(q, k, v, scale, cum_log_forget=None):
    seq = q.shape[1]
    outs = []
    for start in range(0, seq, ATTN_BLOCK):
        end = start + ATTN_BLOCK
        s = jnp.einsum('bqhd,bkhd->bhqk', q[:, start:end], k[:, :end]).astype(jnp.float32) * scale
        if cum_log_forget is not None:
            d_q = jnp.transpose(cum_log_forget[:, start:end], (0, 2, 1))
            d_k = jnp.transpose(cum_log_forget[:, :end], (0, 2, 1))
            s = s + (d_q[..., :, None] - d_k[..., None, :])
        q_pos = jnp.arange(start, end)
        k_pos = jnp.arange(end)
        s = jnp.where(k_pos[None, :] <= q_pos[:, None], s, NEG_INF)
        p = jax.nn.softmax(s, axis=-1).astype(v.dtype)
        outs.append(jnp.einsum('bhqk,bkhd->bqhd', p, v[:, :end]))
    return jnp.concatenate(outs, axis=1)


def mla_mixer(h, cos, sin, wq_a, q_norm, wq_b, wkv_a, kv_norm, wkv_b, wo):
    b, s, _ = h.shape
    c_q = rmsnorm(h @ wq_a, q_norm)
    q = (c_q @ wq_b).reshape(b, s, MLA_HEADS, MLA_NOPE_DIM + MLA_ROPE_DIM)
    q = jnp.concatenate([q[..., :MLA_NOPE_DIM], apply_rope(q[..., MLA_NOPE_DIM:], cos, sin)], axis=-1)
    kv_a = h @ wkv_a
    c_kv = rmsnorm(kv_a[..., :MLA_KV_RANK], kv_norm)
    k_pe = apply_rope(kv_a[..., None, MLA_KV_RANK:], cos, sin)
    kv = (c_kv @ wkv_b).reshape(b, s, MLA_HEADS, MLA_NOPE_DIM + MLA_V_DIM)
    k = jnp.concatenate([kv[..., :MLA_NOPE_DIM],
                         jnp.broadcast_to(k_pe, (b, s, MLA_HEADS, MLA_ROPE_DIM))], axis=-1)
    v = kv[..., MLA_NOPE_DIM:]
    o = causal_block_attention(q, k, v, (MLA_NOPE_DIM + MLA_ROPE_DIM) ** -0.5)
    return o.reshape(b, s, MLA_HEADS * MLA_V_DIM) @ wo


def fox_mixer(h, w_qkv, w_f, b_f, wo):
    b, s, _ = h.shape
    qkv = (h @ w_qkv).reshape(b, s, 3, FOX_HEADS, FOX_HEAD_DIM)
    q, k, v = qkv[:, :, 0], qkv[:, :, 1], qkv[:, :, 2]
    log_f = jax.nn.log_sigmoid((h @ w_f).astype(jnp.float32) + b_f.astype(jnp.float32))
    cum = lax.cumsum(log_f, axis=1)
    o = causal_block_attention(q, k, v, FOX_HEAD_DIM ** -0.5, cum)
    return o.reshape(b, s, FOX_HEADS * FOX_HEAD_DIM) @ wo


def dilated_mixer(h, cos, sin, w_qkv, wo):
    b, s, _ = h.shape
    g_n, hd, dh = DIL_GROUPS, DIL_HEADS, DIL_HEAD_DIM
    qkv = (h @ w_qkv).reshape(b, s, 3, g_n, hd, dh)
    q = apply_rope(qkv[:, :, 0].reshape(b, s, g_n * hd, dh), cos, sin).reshape(b, s, g_n, hd, dh)
    k = apply_rope(qkv[:, :, 1].reshape(b, s, g_n * hd, dh), cos, sin).reshape(b, s, g_n, hd, dh)
    v = qkv[:, :, 2]
    dil = jnp.array([d for _, d in DIL_PATTERNS], dtype=jnp.int32)
    win = jnp.array([w for w, _ in DIL_PATTERNS], dtype=jnp.int32)
    jj = jnp.arange(DIL_KEYS, dtype=jnp.int32)
    offsets = jj[None, :] * dil[:, None]
    in_window = offsets <= win[:, None]
    g_idx = jnp.arange(g_n, dtype=jnp.int32)[:, None, None]
    scale = dh ** -0.5

    def block(start):
        qb = lax.dynamic_slice_in_dim(q, start, DIL_BLOCK, axis=1)
        t = start + jnp.arange(DIL_BLOCK, dtype=jnp.int32)
        idx = t[None, :, None] - offsets[:, None, :]
        valid = (idx >= 0) & in_window[:, None, :]
        idx = jnp.maximum(idx, 0)
        kg = k[:, idx, g_idx]
        vg = v[:, idx, g_idx]
        sc = jnp.einsum('bqghd,bgqjhd->bghqj', qb, kg).astype(jnp.float32) * scale
        sc = jnp.where(valid[None, :, None], sc, NEG_INF)
        m = jnp.max(sc, axis=-1, keepdims=True)
        e = jnp.exp(sc - m)
        den = jnp.sum(e, axis=-1, keepdims=True)
        lse = (m + jnp.log(den))[..., 0]
        o_g = jnp.einsum('bghqj,bgqjhd->bqghd', (e / den).astype(v.dtype), vg)
        w_g = jax.nn.softmax(lse, axis=1)
        return jnp.einsum('bghq,bqghd->bqhd', w_g.astype(v.dtype), o_g)

    starts = jnp.arange(0, s, DIL_BLOCK, dtype=jnp.int32)
    o = lax.map(block, starts)
    o = jnp.moveaxis(o, 0, 1).reshape(b, s, hd * dh)
    return o @ wo


def squared_relu_mlp(h, w_up, w_down):
    return jnp.square(jax.nn.relu(h @ w_up)) @ w_down


def _dense(key, fan_in, fan_out):
    return jax.random.normal(key, (fan_in, fan_out), jnp.float32) * fan_in ** -0.5


def _gain(key, n):
    return 1.0 + 0.05 * jax.random.normal(key, (n,), jnp.float32)


def setup_inputs(seed: int = 0) -> dict:
    key = jax.random.key(seed)
    keys = jax.random.split(key, DEPTH + 2)
    p = {'x': jax.random.normal(keys[0], (BATCH, SEQ, D_MODEL), jnp.float32)}
    for i in range(DEPTH):
        lk = jax.random.split(keys[i + 1], 12)
        pre = 'l%d_' % i
        p[pre + 'attn_norm'] = _gain(lk[0], D_MODEL)
        kind = i % N_MIXERS
        if kind == 0:
            p[pre + 'mla_wq_a'] = _dense(lk[1], D_MODEL, MLA_Q_RANK)
            p[pre + 'mla_q_norm'] = _gain(lk[2], MLA_Q_RANK)
            p[pre + 'mla_wq_b'] = _dense(lk[3], MLA_Q_RANK, MLA_HEADS * (MLA_NOPE_DIM + MLA_ROPE_DIM))
            p[pre + 'mla_wkv_a'] = _dense(lk[4], D_MODEL, MLA_KV_RANK + MLA_ROPE_DIM)
            p[pre + 'mla_kv_norm'] = _gain(lk[5], MLA_KV_RANK)
            p[pre + 'mla_wkv_b'] = _dense(lk[6], MLA_KV_RANK, MLA_HEADS * (MLA_NOPE_DIM + MLA_V_DIM))
            p[pre + 'mla_wo'] = _dense(lk[7], MLA_HEADS * MLA_V_DIM, D_MODEL)
        elif kind == 1:
            p[pre + 'fox_w_qkv'] = _dense(lk[1], D_MODEL, 3 * FOX_HEADS * FOX_HEAD_DIM)
            p[pre + 'fox_w_f'] = _dense(lk[2], D_MODEL, FOX_HEADS)
            p[pre + 'fox_b_f'] = FORGET_BIAS_CENTER + 0.5 * jax.random.normal(lk[3], (FOX_HEADS,), jnp.float32)
            p[pre + 'fox_wo'] = _dense(lk[4], FOX_HEADS * FOX_HEAD_DIM, D_MODEL)
        else:
            p[pre + 'dil_w_qkv'] = _dense(lk[1], D_MODEL, 3 * DIL_GROUPS * DIL_HEADS * DIL_HEAD_DIM)
            p[pre + 'dil_wo'] = _dense(lk[2], DIL_HEADS * DIL_HEAD_DIM, D_MODEL)
        p[pre + 'mlp_norm'] = _gain(lk[8], D_MODEL)
        p[pre + 'w_up'] = _dense(lk[9], D_MODEL, D_FF)
        p[pre + 'w_down'] = _dense(lk[10], D_FF, D_MODEL)
    p['final_norm'] = _gain(keys[DEPTH + 1], D_MODEL)
    return p


def reference(x,
              l0_attn_norm, l0_mla_wq_a, l0_mla_q_norm, l0_mla_wq_b, l0_mla_wkv_a, l0_mla_kv_norm,
              l0_mla_wkv_b, l0_mla_wo, l0_mlp_norm, l0_w_up, l0_w_down,
              l1_attn_norm, l1_fox_w_qkv, l1_fox_w_f, l1_fox_b_f, l1_fox_wo,
              l1_mlp_norm, l1_w_up, l1_w_down,
              l2_attn_norm, l2_dil_w_qkv, l2_dil_wo, l2_mlp_norm, l2_w_up, l2_w_down,
              l3_attn_norm, l3_mla_wq_a, l3_mla_q_norm, l3_mla_wq_b, l3_mla_wkv_a, l3_mla_kv_norm,
              l3_mla_wkv_b, l3_mla_wo, l3_mlp_norm, l3_w_up, l3_w_down,
              final_norm):
    seq = x.shape[1]
    cos_mla, sin_mla = rope_tables(seq, MLA_ROPE_DIM)
    cos_dil, sin_dil = rope_tables(seq, DIL_HEAD_DIM)
    layers = [
        (l0_attn_norm, (l0_mla_wq_a, l0_mla_q_norm, l0_mla_wq_b, l0_mla_wkv_a, l0_mla_kv_norm,
                        l0_mla_wkv_b, l0_mla_wo), l0_mlp_norm, l0_w_up, l0_w_down),
        (l1_attn_norm, (l1_fox_w_qkv, l1_fox_w_f, l1_fox_b_f, l1_fox_wo), l1_mlp_norm, l1_w_up, l1_w_down),
        (l2_attn_norm, (l2_dil_w_qkv, l2_dil_wo), l2_mlp_norm, l2_w_up, l2_w_down),
        (l3_attn_norm, (l3_mla_wq_a, l3_mla_q_norm, l3_mla_wq_b, l3_mla_wkv_a, l3_mla_kv_norm,
                        l3_mla_wkv_b, l3_mla_wo), l3_mlp_norm, l3_w_up, l3_w_down),
    ]
    h = x
    for i in range(DEPTH):
        attn_norm, mixer_params, mlp_norm, w_up, w_down = layers[i]
        a = rmsnorm(h, attn_norm)
        kind = i % N_MIXERS
        if kind == 0:
            a = mla_mixer(a, cos_mla, sin_mla, *mixer_params)
        elif kind == 1:
            a = fox_mixer(a, *mixer_params)
        else:
            a = dilated_mixer(a, cos_dil, sin_dil, *mixer_params)
        h = h + a
        h = h + squared_relu_mlp(rmsnorm(h, mlp_norm), w_up, w_down)
    return rmsnorm(h, final_norm)
```

```cpp
#include <hip/hip_runtime.h>
#include <hip/hip_cooperative_groups.h>
#include <cstdio>
#include <cstdint>
namespace cg = cooperative_groups;
namespace pg8 {
#define PG8_LAS __attribute__((address_space(3)))
typedef unsigned short bf16_t;
typedef short bf16x8 __attribute__((ext_vector_type(8)));
typedef float f32x4 __attribute__((ext_vector_type(4)));
typedef unsigned u32x4 __attribute__((ext_vector_type(4)));
constexpr int BM = 256, BK = 64, HALF = 128, HTB = HALF * BK * 2  , STAGE_BYTES = 8 * HTB, NXCD = 8, WGM = 8;

__host__ __device__ __forceinline__ int lds_byte(int r, int c) { const int st = (r >> 4) * 2 + (c >> 5), rr = r & 15, cc = c & 31, ob = rr * 64 + cc * 2; return st * 1024 + (ob ^ (((ob >> 9) & 1) << 5)); }
__host__ __device__ __forceinline__ void stage_rc(int b, int& R, int& C) { const int st = b / 1024, sb = b % 1024, swz = sb ^ (((sb >> 9) & 1) << 5); R = (st >> 1) * 16 + swz / 64; C = (st & 1) * 32 + (swz % 64) / 2; }
__host__ __device__ __forceinline__ int perm32(int rho) { const int n = rho >> 4, i = rho & 15; return 8 * (i >> 2) + 4 * n + (i & 3); }

struct Unit { int pm, pn; };
struct Gemm { const bf16_t* A; const bf16_t* Bt; int M, N, K; };

struct StaticOrder {
    int nM, nN, nwg, G, c;
    __host__ __device__ void init(int M, int N, int G_, int c_) { nM = M / BM; nN = N / BM; nwg = nM * nN; G = G_; c = c_; }
    __host__ __device__ bool next(int i, Unit& u) const {
        const long L = (long)i * G + c; if (L >= nwg) return false;
        int wgid = (int)L; { const int q = nwg / NXCD, r = nwg % NXCD, xcd = wgid % NXCD, off = wgid / NXCD; wgid = (xcd < r ? xcd * (q + 1) : r * (q + 1) + (xcd - r) * q) + off; }
        const int nig = WGM * nN, gid = wgid / nig, fm = gid * WGM, gsz = (nM - fm) < WGM ? (nM - fm) : WGM;
        u.pm = fm + ((wgid % nig) % gsz); u.pn = (wgid % nig) / gsz; return true;
    }
    __device__ __forceinline__ void a_ready(const Unit&) const {}
    __device__ __forceinline__ void done(const Unit&) const {}
};
__device__ __forceinline__ unsigned cvt_pk_bf16(float lo, float hi) { unsigned r; asm volatile("v_cvt_pk_bf16_f32 %0, %1, %2" : "=v"(r) : "v"(lo), "v"(hi)); return r; }
template <class Epi, class Sched, bool ALIGN_EPI = false, bool SP2 = false>
__device__ __forceinline__ void gemm_phase(PG8_LAS unsigned char* lds, const Gemm g, const Sched& S, const Epi& E) {
    int tid_o = threadIdx.x; asm volatile("" : "+v"(tid_o));
    const int tid = tid_o, wid = __builtin_amdgcn_readfirstlane(tid >> 6), lane = tid & 63, wr = wid >> 2, wc = wid & 3, fr = lane & 15, fq = lane >> 4;
    const int K = g.K, nt = K / BK;
    unsigned voffA[2], voffB[2];
#pragma unroll
    for (int i = 0; i < 2; ++i) { int R, C; stage_rc(tid * 16 + i * 8192, R, C); const int Rb = Epi::PERM ? ((R & ~31) + perm32(R & 31)) : R;
        voffA[i] = (unsigned)(R * K + C) * 2u; voffB[i] = (unsigned)(Rb * K + C) * 2u; }
    const size_t kstep = (size_t)(BK * 2);
    const size_t hstep = (size_t)HALF * K * 2;
    const size_t tstep = 2 * hstep;
    const unsigned ldsw = (unsigned)wid * 1024u;
    const int aoff = lds_byte(wr * 64 + fr, fq * 8), boff = lds_byte(wc * 32 + fr, fq * 8);
#define PG8_SA(b, h) (((b) * 2 + (h)) * HTB)
#define PG8_SB(b, h) ((4 + (b) * 2 + (h)) * HTB)
#define PG8_STAGE(bufoff, gbase, voff) do { _Pragma("unroll") for (int _i = 0; _i < 2; ++_i) \
        __builtin_amdgcn_global_load_lds((const unsigned*)((const char*)(gbase) + (voff)[_i]), (PG8_LAS unsigned*)(lds + (bufoff) + ldsw + _i * 8192), 16, 0, 0); } while (0)
#define PG8_LDA(dst, b, h) do { _Pragma("unroll") for (int m = 0; m < 4; ++m) _Pragma("unroll") for (int k = 0; k < 2; ++k) dst[m][k] = *(const PG8_LAS bf16x8*)(lds + PG8_SA(b, h) + aoff + m * 2048 + k * 1024); } while (0)
#define PG8_LDB(dst, b, h) do { _Pragma("unroll") for (int n = 0; n < 2; ++n) _Pragma("unroll") for (int k = 0; k < 2; ++k) dst[n][k] = *(const PG8_LAS bf16x8*)(lds + PG8_SB(b, h) + boff + n * 2048 + k * 1024); } while (0)
#define PG8_MMA(ai, bj, At, Bt) do { __builtin_amdgcn_s_setprio(1); _Pragma("unroll") for (int m = 0; m < 4; ++m) _Pragma("unroll") for (int n = 0; n < 2; ++n) _Pragma("unroll") for (int k = 0; k < 2; ++k) \
        acc[ai][bj][m][n] = __builtin_amdgcn_mfma_f32_16x16x32_bf16(Bt[n][k], At[m][k], acc[ai][bj][m][n], 0, 0, 0); __builtin_amdgcn_s_setprio(0); } while (0)
#define PG8_WAIT_V(n) asm volatile("s_waitcnt vmcnt(" #n ")" ::: "memory")
#define PG8_WAIT_L(n) asm volatile("s_waitcnt lgkmcnt(" #n ")" ::: "memory")
#define PG8_BAR __builtin_amdgcn_s_barrier()
#define PG8_SCHED __builtin_amdgcn_sched_barrier(0)
    Unit cur, nxt; int ui = 0;
    if (!S.next(0, cur)) return;
    f32x4 acc[2][2][4][2];
#pragma unroll
    for (int a = 0; a < 2; ++a)
#pragma unroll
        for (int b = 0; b < 2; ++b)
#pragma unroll
            for (int m = 0; m < 4; ++m)
#pragma unroll
                for (int n = 0; n < 2; ++n) acc[a][b][m][n] = (f32x4){0.f, 0.f, 0.f, 0.f};
    bf16x8 At[4][2], B0[2][2], B1[2][2];
    const char* cA = (const char*)g.A + (size_t)cur.pm * tstep; const char* cB = (const char*)g.Bt + (size_t)cur.pn * tstep;
    S.a_ready(cur);
    if constexpr (SP2) {
        PG8_STAGE(PG8_SB(0, 0), cB, voffB); PG8_STAGE(PG8_SB(0, 1), cB + hstep, voffB); PG8_STAGE(PG8_SA(0, 0), cA, voffA); PG8_STAGE(PG8_SA(0, 1), cA + hstep, voffA);
        if (wr == 1) PG8_BAR;
        PG8_WAIT_V(2); PG8_BAR;
        PG8_STAGE(PG8_SB(1, 0), cB + kstep, voffB); PG8_STAGE(PG8_SA(1, 0), cA + kstep, voffA); PG8_STAGE(PG8_SB(1, 1), cB + hstep + kstep, voffB);
        PG8_WAIT_V(6); PG8_BAR;
    } else {
        PG8_STAGE(PG8_SB(0, 0), cB, voffB); PG8_STAGE(PG8_SA(0, 0), cA, voffA); PG8_STAGE(PG8_SB(0, 1), cB + hstep, voffB); PG8_STAGE(PG8_SA(0, 1), cA + hstep, voffA);
        if (wr == 1) PG8_BAR;
        PG8_WAIT_V(4); PG8_BAR;
        PG8_STAGE(PG8_SB(1, 0), cB + kstep, voffB); PG8_STAGE(PG8_SA(1, 0), cA + kstep, voffA); PG8_STAGE(PG8_SB(1, 1), cB + hstep + kstep, voffB);
        PG8_WAIT_V(6); PG8_BAR;
    }
    for (;;) {
        const bool has_next = S.next(ui + 1, nxt);
        const char* nA = has_next ? (const char*)g.A + (size_t)nxt.pm * tstep : cA; const char* nB = has_next ? (const char*)g.Bt + (size_t)nxt.pn * tstep : cB;
#pragma nounroll
        for (int t = 0; t < nt; t += 2) {
            const bool last = (t == nt - 2);
            const char* a1 = cA + (size_t)(t + 1) * kstep;
            const char* a2 = last ? nA : cA + (size_t)(t + 2) * kstep; const char* b2 = last ? nB : cB + (size_t)(t + 2) * kstep;
            const char* a3 = a2 + kstep; const char* b3 = b2 + kstep;
            if (last && has_next) S.a_ready(nxt);
            if constexpr (SP2) {
            PG8_LDB(B0, 0, 0); PG8_LDB(B1, 0, 1); PG8_SCHED; PG8_LDA(At, 0, 0); PG8_STAGE(PG8_SA(1, 1), a1 + hstep, voffA);
            PG8_WAIT_V(8); PG8_WAIT_L(0); PG8_BAR; PG8_MMA(0, 0, At, B0); PG8_MMA(0, 1, At, B1); PG8_BAR; PG8_SCHED;
            PG8_LDA(At, 0, 1); PG8_STAGE(PG8_SB(0, 0), b2, voffB); PG8_STAGE(PG8_SB(0, 1), b2 + hstep, voffB); PG8_STAGE(PG8_SA(0, 0), a2, voffA);
            PG8_WAIT_V(8); PG8_WAIT_L(0); PG8_BAR; PG8_MMA(1, 0, At, B0); PG8_MMA(1, 1, At, B1); PG8_BAR; PG8_SCHED;
            PG8_LDB(B0, 1, 0); PG8_LDB(B1, 1, 1); PG8_SCHED; PG8_LDA(At, 1, 0); PG8_STAGE(PG8_SA(0, 1), a2 + hstep, voffA);
            PG8_WAIT_V(8); PG8_WAIT_L(0); PG8_BAR; PG8_MMA(0, 0, At, B0); PG8_MMA(0, 1, At, B1); PG8_BAR; PG8_SCHED;
            PG8_LDA(At, 1, 1); PG8_STAGE(PG8_SB(1, 0), b3, voffB); PG8_STAGE(PG8_SB(1, 1), b3 + hstep, voffB); PG8_STAGE(PG8_SA(1, 0), a3, voffA);
            PG8_WAIT_V(8); PG8_WAIT_L(0); PG8_BAR; PG8_MMA(1, 0, At, B0); PG8_MMA(1, 1, At, B1); PG8_BAR; PG8_SCHED;
            } else {
            PG8_LDB(B0, 0, 0); PG8_SCHED; PG8_LDA(At, 0, 0); PG8_STAGE(PG8_SA(1, 1), a1 + hstep, voffA);
            PG8_WAIT_L(8); PG8_BAR; PG8_WAIT_L(0); PG8_MMA(0, 0, At, B0); PG8_BAR; PG8_SCHED;
            PG8_LDB(B1, 0, 1); PG8_STAGE(PG8_SB(0, 0), b2, voffB);
            PG8_BAR; PG8_WAIT_L(0); PG8_MMA(0, 1, At, B1); PG8_BAR;
            PG8_LDA(At, 0, 1); PG8_STAGE(PG8_SA(0, 0), a2, voffA);
            PG8_BAR; PG8_WAIT_L(0); PG8_MMA(1, 0, At, B0); PG8_BAR; PG8_SCHED;
            PG8_STAGE(PG8_SB(0, 1), b2 + hstep, voffB);
            PG8_WAIT_V(6); PG8_BAR; PG8_MMA(1, 1, At, B1); PG8_BAR;
            PG8_LDB(B0, 1, 0); PG8_SCHED; PG8_LDA(At, 1, 0); PG8_STAGE(PG8_SA(0, 1), a2 + hstep, voffA);
            PG8_WAIT_L(8); PG8_BAR; PG8_WAIT_L(0); PG8_MMA(0, 0, At, B0); PG8_BAR; PG8_SCHED;
            PG8_LDB(B1, 1, 1); PG8_STAGE(PG8_SB(1, 0), b3, voffB);
            PG8_BAR; PG8_WAIT_L(0); PG8_MMA(0, 1, At, B1); PG8_BAR;
            PG8_LDA(At, 1, 1); PG8_STAGE(PG8_SA(1, 0), a3, voffA);
            PG8_BAR; PG8_WAIT_L(0); PG8_MMA(1, 0, At, B0); PG8_BAR; PG8_SCHED;
            PG8_STAGE(PG8_SB(1, 1), b3 + hstep, voffB);
            PG8_WAIT_V(6); PG8_BAR; PG8_MMA(1, 1, At, B1); PG8_BAR;
            }
        }
        if constexpr (ALIGN_EPI) { if (wr == 0) PG8_BAR; }
        if constexpr (!Epi::AFTER_DRAIN) { E(acc, cur, wr, wc, fr, fq); S.done(cur); }
        if (!has_next) break;
#pragma unroll
        for (int a = 0; a < 2; ++a)
#pragma unroll
            for (int b = 0; b < 2; ++b)
#pragma unroll
                for (int m = 0; m < 4; ++m)
#pragma unroll
                    for (int n = 0; n < 2; ++n) acc[a][b][m][n] = (f32x4){0.f, 0.f, 0.f, 0.f};
        cur = nxt; cA = nA; cB = nB; ++ui;
        if constexpr (ALIGN_EPI) { if (wr == 1) PG8_BAR; }
    }
    PG8_WAIT_V(0);
    if constexpr (!ALIGN_EPI) { if (wr == 0) PG8_BAR; }
    PG8_BAR;
    if constexpr (Epi::AFTER_DRAIN) { E.fused(acc, cur, wr, wc, fr, fq, lds, wid, lane); S.done(cur); }
#undef PG8_SA
#undef PG8_SB
#undef PG8_STAGE
#undef PG8_LDA
#undef PG8_LDB
#undef PG8_MMA
#undef PG8_WAIT_V
#undef PG8_WAIT_L
#undef PG8_BAR
#undef PG8_SCHED
}
}

#define LAS __attribute__((address_space(3)))
typedef unsigned short bf16_t;
typedef short bf16x8 __attribute__((ext_vector_type(8)));
typedef float f32x4 __attribute__((ext_vector_type(4)));
typedef float f32x2 __attribute__((ext_vector_type(2)));
typedef float f32x16 __attribute__((ext_vector_type(16)));
typedef unsigned u32x4 __attribute__((ext_vector_type(4)));
typedef unsigned u32x2 __attribute__((ext_vector_type(2)));
#define DI __device__ __forceinline__
#define GAS __attribute__((address_space(1)))

constexpr int T_TOK = 32768, DM = 1024, SEQ = 4096, NB = 8, DFF = 4096;
constexpr float EPS = 1e-6f;
constexpr float LOG2E = 1.4426950408889634f;
constexpr float QS_MLA = 0.10206207261596577f * 1.4426950408889634f;
constexpr float QS_64 = 0.125f * 1.4426950408889634f;

constexpr size_t MiB = 1u << 20;
constexpr size_t WS_COSM = 1 * MiB, WS_SINM = WS_COSM + 256 * 1024, WS_COSD = WS_SINM + 256 * 1024, WS_SIND = WS_COSD + 512 * 1024;
constexpr size_t WS_P16 = 3 * MiB;
constexpr size_t WS_PQ = 5 * MiB;
constexpr size_t WS_PKV = 6 * MiB;
constexpr size_t WS_W = 8 * MiB;
constexpr size_t WS_W1 = 474 * MiB;
constexpr size_t WS_HB = 48 * MiB;
constexpr size_t WS_R = 112 * MiB;
constexpr size_t WS_X0 = 464 * MiB;
constexpr size_t WS_LOGF = WS_X0;
constexpr size_t WS_DL = WS_X0 + 2 * MiB;
constexpr size_t WS_KPE = WS_X0 + 4 * MiB;
constexpr size_t WS_LSE = WS_X0 + 6 * MiB;
constexpr size_t WS_NEED = 510 * MiB;
constexpr size_t WO_MIX = 0, WO_QB = 786432, WO_KVB = 1376256, WO_WO = 9437184, WO_UP = 10485760, WO_DOWN = 14680064;
constexpr size_t R_CKV = 0, R_CQ = 16 * MiB, R_Q = 40 * MiB, R_KV = 136 * MiB, R_O_MLA = 264 * MiB;
constexpr size_t R_QKV = 0, R_O_FOX = 192 * MiB, R_O_DIL = 288 * MiB, R_U = 0;

constexpr int LDS_BYTES = 147456;
constexpr bool RES_LO = false;

__device__ const float INV16[16] = {1.000000000e+00f, 5.623413324e-01f, 3.162277639e-01f, 1.778279394e-01f, 1.000000015e-01f, 5.623412877e-02f, 3.162277862e-02f, 1.778279431e-02f, 9.999999776e-03f, 5.623413250e-03f, 3.162277862e-03f, 1.778279431e-03f, 1.000000047e-03f, 5.623413017e-04f, 3.162277862e-04f, 1.778279402e-04f};
__device__ const float INV32[32] = {1.000000000e+00f, 7.498942018e-01f, 5.623413324e-01f, 4.216965139e-01f, 3.162277639e-01f, 2.371373922e-01f, 1.778279394e-01f, 1.333521456e-01f, 1.000000015e-01f, 7.498941571e-02f, 5.623412877e-02f, 4.216964915e-02f, 3.162277862e-02f, 2.371373586e-02f, 1.778279431e-02f, 1.333521493e-02f, 9.999999776e-03f, 7.498942316e-03f, 5.623413250e-03f, 4.216964822e-03f, 3.162277862e-03f, 2.371373819e-03f, 1.778279431e-03f, 1.333521446e-03f, 1.000000047e-03f, 7.498941850e-04f, 5.623413017e-04f, 4.216965463e-04f, 3.162277862e-04f, 2.371373848e-04f, 1.778279402e-04f, 1.333521504e-04f};

typedef __bf16 bf16x2_t __attribute__((ext_vector_type(2)));
DI unsigned cvtpk(float lo, float hi) { const f32x2 v = {lo, hi}; const bf16x2_t b = __builtin_convertvector(v, bf16x2_t); return __builtin_bit_cast(unsigned, b); }
DI void st_bf16x4(bf16_t* p, f32x4 v) { u32x2 w; w.x = cvtpk(v.x, v.y); w.y = cvtpk(v.z, v.w); *(GAS u32x2*)p = w; }
DI f32x4 ldg4(const float* p) { return *(const GAS f32x4*)p; }
DI void stg4(float* p, f32x4 v) { *(GAS f32x4*)p = v; }
DI float dot4(f32x4 v) { return (v.x * v.x + v.y * v.y) + (v.z * v.z + v.w * v.w); }
DI float quad_sum(float s) { s += __shfl_xor(s, 16); s += __shfl_xor(s, 32); return s; }
DI float sum_part(const float* p, int n4) { float s = 0.f; for (int i = 0; i < n4; ++i) { const f32x4 v = ((const f32x4*)p)[i]; s += (v.x + v.y) + (v.z + v.w); } return s; }
DI float wave_sum(float v) {
#pragma unroll
    for (int o = 1; o < 64; o <<= 1) v += __shfl_xor(v, o);
    return v;
}

DI int otid() { int t = threadIdx.x; asm volatile("" : "+v"(t)); return t; }
DI int obid() { int b = blockIdx.x; asm volatile("" : "+s"(b)); return b; }
typedef f32x4 Acc[2][2][4][2];
#define EROW(ai, m) (u.pm * 256 + (ai) * 128 + wr * 64 + (m) * 16 + fr)
#define ECOL(bj, n) (u.pn * 256 + (bj) * 128 + wc * 32 + (n) * 16 + fq * 4)
#define EFENCE() asm volatile("" ::: "memory")

typedef unsigned long long u64;
constexpr float FX_SCALE = 1048576.f, FX_INV = 1.f / 1048576.f;
DI float ld_dev(const u64* p) { return (float)__hip_atomic_load((const GAS u64*)p, __ATOMIC_RELAXED, __HIP_MEMORY_SCOPE_AGENT) * FX_INV; }
DI void st_dev(u64* p, float v) { __hip_atomic_store((GAS u64*)p, (u64)(v * FX_SCALE), __ATOMIC_RELAXED, __HIP_MEMORY_SCOPE_AGENT); }
DI void atomic_addf(u64* p, float v) { __hip_atomic_fetch_add((GAS u64*)p, (u64)(v * FX_SCALE), __ATOMIC_RELAXED, __HIP_MEMORY_SCOPE_AGENT); }
DI void st_bf16x8(bf16_t* p, f32x4 a, f32x4 b) { u32x4 w; w.x = cvtpk(a.x, a.y); w.y = cvtpk(a.z, a.w); w.z = cvtpk(b.x, b.y); w.w = cvtpk(b.z, b.w); *(GAS u32x4*)p = w; }
DI float bflo(unsigned w) { return __uint_as_float(w << 16); }
DI float bfhi(unsigned w) { return __uint_as_float(w & 0xffff0000u); }
DI u32x2 split2(float a, float b) { u32x2 r; r.x = cvtpk(a, b); r.y = cvtpk(a - bflo(r.x), b - bfhi(r.x)); return r; }
#define ECOLP(bj) (u.pn * 256 + (bj) * 128 + wc * 32 + fq * 8)
struct EpiRes {
    static constexpr bool PERM = true, AFTER_DRAIN = false;
    bf16_t* hi; const bf16_t* lo_in; bf16_t* lo_out; u64* ssq;
    DI void operator()(const Acc& acc, const pg8::Unit& u, int wr, int wc, int fr, int fq) const {
#pragma unroll
        for (int ai = 0; ai < 2; ++ai)
#pragma unroll
          for (int mh = 0; mh < 2; ++mh) {
            u32x4 hh[2][2], ll[2][2];
#pragma unroll
            for (int m2 = 0; m2 < 2; ++m2)
#pragma unroll
                for (int bj = 0; bj < 2; ++bj) { const size_t off = (size_t)EROW(ai, 2 * mh + m2) * DM + ECOLP(bj); hh[m2][bj] = *(const GAS u32x4*)(hi + off); ll[m2][bj] = RES_LO ? *(const GAS u32x4*)(lo_in + off) : (u32x4){0u, 0u, 0u, 0u}; }
#pragma unroll
            for (int m2 = 0; m2 < 2; ++m2) {
                const int m = 2 * mh + m2;
                const size_t row = EROW(ai, m); float ss = 0.f;
#pragma unroll
                for (int bj = 0; bj < 2; ++bj) {
                    const size_t off = row * DM + ECOLP(bj);
                    const u32x4 H = hh[m2][bj], L = ll[m2][bj]; const f32x4 a0 = acc[ai][bj][m][0], a1 = acc[ai][bj][m][1];
                    float v[8];
                    v[0] = bflo(H.x) + bflo(L.x) + a0.x; v[1] = bfhi(H.x) + bfhi(L.x) + a0.y; v[2] = bflo(H.y) + bflo(L.y) + a0.z; v[3] = bfhi(H.y) + bfhi(L.y) + a0.w;
                    v[4] = bflo(H.z) + bflo(L.z) + a1.x; v[5] = bfhi(H.z) + bfhi(L.z) + a1.y; v[6] = bflo(H.w) + bflo(L.w) + a1.z; v[7] = bfhi(H.w) + bfhi(L.w) + a1.w;
                    u32x4 nh, nl;
                    { const u32x2 s0 = split2(v[0], v[1]), s1 = split2(v[2], v[3]), s2 = split2(v[4], v[5]), s3 = split2(v[6], v[7]); nh.x = s0.x; nl.x = s0.y; nh.y = s1.x; nl.y = s1.y; nh.z = s2.x; nl.z = s2.y; nh.w = s3.x; nl.w = s3.y; }
                    *(GAS u32x4*)(hi + off) = nh; if (RES_LO) *(GAS u32x4*)(lo_out + off) = nl;
#pragma unroll
                    for (int k = 0; k < 8; ++k) ss += v[k] * v[k];
                }
                ss = quad_sum(ss);
                if (fq == 0) atomic_addf(ssq + row, ss);
            }
            EFENCE();
        }
    }
};
struct EpiUp {
    static constexpr bool PERM = true, AFTER_DRAIN = false;
    const u64* ssq; bf16_t* out;
    DI void operator()(const Acc& acc, const pg8::Unit& u, int wr, int wc, int fr, int fq) const {
        float rs[2][4];
#pragma unroll
        for (int ai = 0; ai < 2; ++ai)
#pragma unroll
            for (int m = 0; m < 4; ++m) rs[ai][m] = ld_dev(ssq + EROW(ai, m));
#pragma unroll
        for (int ai = 0; ai < 2; ++ai)
#pragma unroll
            for (int m = 0; m < 4; ++m) {
                const size_t row = EROW(ai, m);
                const float r = rsqrtf(rs[ai][m] * (1.f / 1024.f) + EPS);
#pragma unroll
                for (int bj = 0; bj < 2; ++bj) {
                    f32x4 v0 = acc[ai][bj][m][0] * r, v1 = acc[ai][bj][m][1] * r;
                    v0.x = fmaxf(v0.x, 0.f); v0.y = fmaxf(v0.y, 0.f); v0.z = fmaxf(v0.z, 0.f); v0.w = fmaxf(v0.w, 0.f);
                    v1.x = fmaxf(v1.x, 0.f); v1.y = fmaxf(v1.y, 0.f); v1.z = fmaxf(v1.z, 0.f); v1.w = fmaxf(v1.w, 0.f);
                    st_bf16x8(out + row * DFF + ECOLP(bj), v0 * v0, v1 * v1);
                }
            }
    }
};
struct EpiMlaA {
    static constexpr bool PERM = true, AFTER_DRAIN = false;
    const u64* ssq; bf16_t* ckv; bf16_t* cq; bf16_t* kpe; u64* sq; u64* skv; const float* cosM; const float* sinM;
    DI void operator()(const Acc& acc, const pg8::Unit& u, int wr, int wc, int fr, int fq) const {
        float rsv[2][4];
#pragma unroll
        for (int ai = 0; ai < 2; ++ai)
#pragma unroll
            for (int m = 0; m < 4; ++m) rsv[ai][m] = ld_dev(ssq + EROW(ai, m));
#pragma unroll
        for (int ai = 0; ai < 2; ++ai)
#pragma unroll
            for (int m = 0; m < 4; ++m) {
                const size_t row = EROW(ai, m);
                const float rs = rsqrtf(rsv[ai][m] * (1.f / 1024.f) + EPS);
                float ss = 0.f;
                if (u.pn == 0) {
#pragma unroll
                    for (int bj = 0; bj < 2; ++bj) { const f32x4 v0 = acc[ai][bj][m][0] * rs, v1 = acc[ai][bj][m][1] * rs; ss += dot4(v0) + dot4(v1); st_bf16x8(ckv + row * 256 + bj * 128 + wc * 32 + fq * 8, v0, v1); }
                    ss = quad_sum(ss); if (fq == 0) atomic_addf(skv + row, ss);
                } else if (u.pn == 1) {
#pragma unroll
                    for (int bj = 0; bj < 2; ++bj) { const f32x4 v0 = acc[ai][bj][m][0] * rs, v1 = acc[ai][bj][m][1] * rs; ss += dot4(v0) + dot4(v1); st_bf16x8(cq + row * 384 + bj * 128 + wc * 32 + fq * 8, v0, v1); }
                    ss = quad_sum(ss); if (fq == 0) atomic_addf(sq + row, ss);
                } else {
                    { const f32x4 v0 = acc[ai][0][m][0] * rs, v1 = acc[ai][0][m][1] * rs; ss += dot4(v0) + dot4(v1); st_bf16x8(cq + row * 384 + 256 + wc * 32 + fq * 8, v0, v1); }
                    ss = quad_sum(ss); if (fq == 0) atomic_addf(sq + row, ss);
                    if (wc == 0) {
                        const int pos = (int)(row & (SEQ - 1));
                        const f32x4 c = ldg4(cosM + pos * 16 + fq * 4), s = ldg4(sinM + pos * 16 + fq * 4);
                        const f32x4 x1 = acc[ai][1][m][0] * rs, x2 = acc[ai][1][m][1] * rs;
                        st_bf16x8(kpe + row * 32 + fq * 8, x1 * c - x2 * s, x1 * s + x2 * c);
                    }
                }
            }
    }
};
struct EpiMlaQ {
    static constexpr bool PERM = true, AFTER_DRAIN = false;
    const u64* sq; bf16_t* Q; const float* cosM; const float* sinM;
    DI void operator()(const Acc& acc, const pg8::Unit& u, int wr, int wc, int fr, int fq) const {
        float rsv[2][4];
#pragma unroll
        for (int ai = 0; ai < 2; ++ai)
#pragma unroll
            for (int m = 0; m < 4; ++m) rsv[ai][m] = ld_dev(sq + EROW(ai, m));
#pragma unroll
        for (int ai = 0; ai < 2; ++ai)
#pragma unroll
            for (int m = 0; m < 4; ++m) {
                const size_t row = EROW(ai, m);
                const float rs = rsqrtf(rsv[ai][m] * (1.f / 384.f) + EPS) * QS_MLA;
                const int toff = (int)(row & (SEQ - 1)) * 16 + fq * 4;
#pragma unroll
                for (int bj = 0; bj < 2; ++bj) {
                    const int g32 = 8 * u.pn + 4 * bj + wc;
                    bf16_t* dst = Q + row * 1536 + ECOLP(bj);
                    const f32x4 x1 = acc[ai][bj][m][0] * rs, x2 = acc[ai][bj][m][1] * rs;
                    if (g32 % 3 == 2) {
                        const f32x4 c = ldg4(cosM + toff), s = ldg4(sinM + toff);
                        st_bf16x8(dst, x1 * c - x2 * s, x1 * s + x2 * c);
                    } else st_bf16x8(dst, x1, x2);
                }
            }
    }
};
struct EpiMlaKV {
    static constexpr bool PERM = true, AFTER_DRAIN = false;
    const u64* skv; bf16_t* KV;
    DI void operator()(const Acc& acc, const pg8::Unit& u, int wr, int wc, int fr, int fq) const {
        float rsv[2][4];
#pragma unroll
        for (int ai = 0; ai < 2; ++ai)
#pragma unroll
            for (int m = 0; m < 4; ++m) rsv[ai][m] = ld_dev(skv + EROW(ai, m));
#pragma unroll
        for (int ai = 0; ai < 2; ++ai)
#pragma unroll
            for (int m = 0; m < 4; ++m) {
                const size_t row = EROW(ai, m);
                const float rs = rsqrtf(rsv[ai][m] * (1.f / 256.f) + EPS);
#pragma unroll
                for (int bj = 0; bj < 2; ++bj) st_bf16x8(KV + row * 2048 + ECOLP(bj), acc[ai][bj][m][0] * rs, acc[ai][bj][m][1] * rs);
            }
    }
};
struct EpiFox {
    static constexpr bool PERM = true, AFTER_DRAIN = false;
    const u64* ssq; bf16_t* qkv; float* logf; const float* bf;
    DI void operator()(const Acc& acc, const pg8::Unit& u, int wr, int wc, int fr, int fq) const {
        float rsv[2][4];
#pragma unroll
        for (int ai = 0; ai < 2; ++ai)
#pragma unroll
            for (int m = 0; m < 4; ++m) rsv[ai][m] = ld_dev(ssq + EROW(ai, m));
#pragma unroll
        for (int ai = 0; ai < 2; ++ai)
#pragma unroll
            for (int m = 0; m < 4; ++m) {
                const size_t row = EROW(ai, m);
                const float rs = rsqrtf(rsv[ai][m] * (1.f / 1024.f) + EPS);
                if (u.pn < 12) {
                    const float sc = (u.pn < 4) ? rs * QS_64 : rs;
#pragma unroll
                    for (int bj = 0; bj < 2; ++bj) st_bf16x8(qkv + row * 3072 + ECOLP(bj), acc[ai][bj][m][0] * sc, acc[ai][bj][m][1] * sc);
                } else if (wc == 0 && fq < 2) {
#pragma unroll
                    for (int n = 0; n < 2; ++n) {
                        const f32x4 b = ldg4(bf + fq * 8 + 4 * n); const f32x4 x = acc[ai][0][m][n] * rs + b; f32x4 o;
#pragma unroll
                        for (int e = 0; e < 4; ++e) { const float xv = x[e]; o[e] = fminf(xv, 0.f) - __logf(1.f + __expf(-fabsf(xv))); }
                        stg4(logf + row * 16 + fq * 8 + 4 * n, o);
                    }
                }
            }
    }
};
struct EpiDil {
    static constexpr bool PERM = true, AFTER_DRAIN = false;
    const u64* ssq; bf16_t* qkv; const float* cosD; const float* sinD;
    DI void operator()(const Acc& acc, const pg8::Unit& u, int wr, int wc, int fr, int fq) const {
        const int sel = u.pn / 12;
        const int gg = (u.pn % 12) >> 2, ld = 2 * gg;
        float rsv[2][4];
#pragma unroll
        for (int ai = 0; ai < 2; ++ai)
#pragma unroll
            for (int m = 0; m < 4; ++m) rsv[ai][m] = ld_dev(ssq + EROW(ai, m));
#pragma unroll
        for (int ai = 0; ai < 2; ++ai)
#pragma unroll
            for (int m = 0; m < 4; ++m) {
                const size_t row = EROW(ai, m);
                const float rs0 = rsqrtf(rsv[ai][m] * (1.f / 1024.f) + EPS);
                const float rs = (sel == 0) ? rs0 * QS_64 : rs0;
                const int pos = (int)(row & (SEQ - 1));
                const int rho = ((pos & ((1 << ld) - 1)) << (12 - ld)) + (pos >> ld);
                f32x4 c = {0.f, 0.f, 0.f, 0.f}, s = c;
                if (sel < 2) { const int i0 = 16 * (wc & 1) + fq * 4; c = ldg4(cosD + pos * 32 + i0); s = ldg4(sinD + pos * 32 + i0); }
#pragma unroll
                for (int bj = 0; bj < 2; ++bj) {
                    f32x4 x1 = acc[ai][bj][m][0] * rs, x2 = acc[ai][bj][m][1] * rs;
                    if (sel < 2) { const f32x4 o1 = x1 * c - x2 * s, o2 = x1 * s + x2 * c; x1 = o1; x2 = o2; }
                    const int hd = ((u.pn & 3) << 2) + 2 * bj + (wc >> 1);
                    bf16_t* dst = qkv + ((size_t)((((int)(row >> 12) * 3 + sel) * 3 + gg) * 16 + hd) * 4096 + rho) * 64 + 32 * (wc & 1) + 8 * fq;
                    st_bf16x8(dst, x1, x2);
                }
            }
    }
};

DI void store_o_row(bf16_t* orow, const f32x16& o0, const f32x16& o1, float inv, int h) {
#pragma unroll
    for (int blk = 0; blk < 2; ++blk)
#pragma unroll
        for (int gp = 0; gp < 2; ++gp) {
            const f32x16& o = blk ? o1 : o0;
            const int ge = 8 * gp, go = 8 * gp + 4;
            const unsigned e0 = cvtpk(o[ge] * inv, o[ge + 1] * inv), e1 = cvtpk(o[ge + 2] * inv, o[ge + 3] * inv);
            const unsigned q0 = cvtpk(o[go] * inv, o[go + 1] * inv), q1 = cvtpk(o[go + 2] * inv, o[go + 3] * inv);
            const auto s0 = __builtin_amdgcn_permlane32_swap(e0, q0, false, false);
            const auto s1 = __builtin_amdgcn_permlane32_swap(e1, q1, false, false);
            u32x4 w; w.x = s0[0]; w.y = s1[0]; w.z = s0[1]; w.w = s1[1];
            *(GAS u32x4*)(orow + 32 * blk + 16 * gp + 8 * h) = w;
        }
}
typedef short v4i16_t __attribute__((ext_vector_type(4)));
DI bf16x8 vtr8(const LAS unsigned char* p, int row_pitch4) {
    const v4i16_t lo = __builtin_amdgcn_ds_read_tr16_b64_v4i16((LAS v4i16_t*)p), hi = __builtin_amdgcn_ds_read_tr16_b64_v4i16((LAS v4i16_t*)(p + row_pitch4));
    return (bf16x8){lo[0], lo[1], lo[2], lo[3], hi[0], hi[1], hi[2], hi[3]};
}
#define AT_VTR(p) vtr8((p), 4 * VP)
template <int DK, int MODE>
DI void attn_unit(LAS unsigned char* lds, const bf16_t* Qp, long qpitch, const bf16_t* Kp, long kpitch, const bf16_t* K2p, long k2pitch,
                  const bf16_t* Vp, long vpitch, bf16_t* Op, long opitch, const float* Dl, float* lsep, long lsepitch, int q0, int W,
                  bool pre, bool has_next, const bf16_t* Kn, const bf16_t* K2n, const bf16_t* Vn, const float* Dln,
                  u32x4& kreg0, u32x4& kreg1, u32x4& k2reg, u32x4& vreg0, u32x4& vreg1, f32x4& dkreg) {
    constexpr int KP = DK * 2 + 16, NS = DK / 16, VP = 192, VT_OFF = 128 * 208, DK_OFF = VT_OFF + 128 * VP, BUFSZ = 52224;
    static_assert(DK_OFF + 512 <= BUFSZ, "lds");
    constexpr float THR = 8.f;
    const int tid = otid(), lane = tid & 63, r = lane & 31, h = lane >> 5;
    const int wid = __builtin_amdgcn_readfirstlane(tid >> 6);
    const int wq0 = q0 + 32 * wid, q = wq0 + r;
    bf16x8 qf[NS];
    { const bf16_t* qrow = Qp + (long)q * qpitch;
#pragma unroll
      for (int s = 0; s < NS; ++s) qf[s] = *(const GAS bf16x8*)(qrow + 16 * s + 8 * h); }
    float dq = 0.f; if (MODE == 1) dq = *(const GAS float*)(Dl + q);
    f32x16 o0, o1;
#pragma unroll
    for (int i = 0; i < 16; ++i) { o0[i] = 0.f; o1[i] = 0.f; }
    float m_ref = 0.f, l_run = 0.f; bool first = true;
    const int t_lo = 0; (void)W;
    const int t_hi = (q0 + 255) >> 7;
    const int lkey = tid >> 3, lch = tid & 7;
#define AT_ISSUE(t) do { const long kb_ = 128L * (t); \
        kreg0 = *(const GAS u32x4*)(Kp + (kb_ + lkey) * kpitch + lch * 8); kreg1 = *(const GAS u32x4*)(Kp + (kb_ + lkey + 64) * kpitch + lch * 8); \
        if (MODE == 0) k2reg = *(const GAS u32x4*)(K2p + (kb_ + (tid >> 2)) * k2pitch + (tid & 3) * 8); \
        vreg0 = *(const GAS u32x4*)(Vp + (kb_ + lkey) * vpitch + lch * 8); vreg1 = *(const GAS u32x4*)(Vp + (kb_ + lkey + 64) * vpitch + lch * 8); \
        if (MODE == 1 && tid < 32) dkreg = *(const GAS f32x4*)(Dl + kb_ + 4 * tid); } while (0)
#define AT_WRITE(bufp) do { LAS unsigned char* b_ = (bufp); \
        *(LAS u32x4*)(b_ + lkey * KP + lch * 16) = kreg0; *(LAS u32x4*)(b_ + (lkey + 64) * KP + lch * 16) = kreg1; \
        if (MODE == 0) *(LAS u32x4*)(b_ + (tid >> 2) * KP + 128 + (tid & 3) * 16) = k2reg; \
        *(LAS u32x4*)(b_ + VT_OFF + lkey * VP + lch * 16) = vreg0; *(LAS u32x4*)(b_ + VT_OFF + (lkey + 64) * VP + lch * 16) = vreg1; \
        if (MODE == 1 && tid < 32) *(LAS f32x4*)(b_ + DK_OFF + 16 * tid) = dkreg; } while (0)
#define AT_ISSUE_NEXT() do { \
        kreg0 = *(const GAS u32x4*)(Kn + (long)lkey * kpitch + lch * 8); kreg1 = *(const GAS u32x4*)(Kn + (long)(lkey + 64) * kpitch + lch * 8); \
        if (MODE == 0) k2reg = *(const GAS u32x4*)(K2n + (long)(tid >> 2) * k2pitch + (tid & 3) * 8); \
        vreg0 = *(const GAS u32x4*)(Vn + (long)lkey * vpitch + lch * 8); vreg1 = *(const GAS u32x4*)(Vn + (long)(lkey + 64) * vpitch + lch * 8); \
        if (MODE == 1 && tid < 32) dkreg = *(const GAS f32x4*)(Dln + 4 * tid); } while (0)
    if (!pre) AT_ISSUE(t_lo);
    AT_WRITE(lds + (t_lo & 1) * BUFSZ);
    if (t_lo < t_hi) AT_ISSUE(t_lo + 1);
    __syncthreads();
    const int pr = (r & 19) | ((r & 4) << 1) | ((r & 8) >> 1);
    const int vtr_base = (8 * h + ((lane & 15) >> 2)) * VP + (16 * ((lane >> 4) & 1) + 4 * (lane & 3)) * 2;
#define AT_S(P0, P1, SUB) do { \
        const LAS unsigned char* ka_ = buf + (64 * (SUB) + pr) * KP + h * 16; constexpr int NH = NS / 2; bf16x8 kf[2 * NH]; \
        _Pragma("unroll") for (int s = 0; s < NH; ++s) { kf[2 * s] = *(const LAS bf16x8*)(ka_ + s * 32); kf[2 * s + 1] = *(const LAS bf16x8*)(ka_ + 32 * KP + s * 32); } \
        f32x16 i0_, i1_; \
        if (MODE == 1) { const float base = dq - m_ref; const LAS unsigned char* dk_ = buf + DK_OFF + 256 * (SUB); \
            _Pragma("unroll") for (int a = 0; a < 2; ++a) { \
                const f32x4 d0 = *(const LAS f32x4*)(dk_ + 4 * (16 * a + 8 * h)), d1 = *(const LAS f32x4*)(dk_ + 4 * (16 * a + 8 * h + 4)); \
                const f32x4 e0 = *(const LAS f32x4*)(dk_ + 4 * (32 + 16 * a + 8 * h)), e1 = *(const LAS f32x4*)(dk_ + 4 * (32 + 16 * a + 8 * h + 4)); \
                _Pragma("unroll") for (int e = 0; e < 4; ++e) { i0_[8 * a + e] = base - d0[e]; i0_[8 * a + 4 + e] = base - d1[e]; i1_[8 * a + e] = base - e0[e]; i1_[8 * a + 4 + e] = base - e1[e]; } } } \
        else { _Pragma("unroll") for (int i = 0; i < 16; ++i) { i0_[i] = -m_ref; i1_[i] = -m_ref; } } \
        \
        P0 = __builtin_amdgcn_mfma_f32_32x32x16_bf16(kf[0], qf[0], i0_, 0, 0, 0); P1 = __builtin_amdgcn_mfma_f32_32x32x16_bf16(kf[1], qf[0], i1_, 0, 0, 0); \
        _Pragma("unroll") for (int s = 1; s < NH; ++s) { \
            P0 = __builtin_amdgcn_mfma_f32_32x32x16_bf16(kf[2 * s], qf[s], P0, 0, 0, 0); P1 = __builtin_amdgcn_mfma_f32_32x32x16_bf16(kf[2 * s + 1], qf[s], P1, 0, 0, 0); } \
        _Pragma("unroll") for (int s = 0; s < NH; ++s) { kf[2 * s] = *(const LAS bf16x8*)(ka_ + (NH + s) * 32); kf[2 * s + 1] = *(const LAS bf16x8*)(ka_ + 32 * KP + (NH + s) * 32); } \
        \
        _Pragma("unroll") for (int s = 0; s < NH; ++s) { \
            P0 = __builtin_amdgcn_mfma_f32_32x32x16_bf16(kf[2 * s], qf[NH + s], P0, 0, 0, 0); P1 = __builtin_amdgcn_mfma_f32_32x32x16_bf16(kf[2 * s + 1], qf[NH + s], P1, 0, 0, 0); } \
        } while (0)
#define AT_SM(P0, P1, SUB, ADJ, OTH0, OTH1) do { \
        const int kb_ = 128 * t + 64 * (SUB); \
        const LAS unsigned char* va_ = buf + VT_OFF + vtr_base + 64 * (SUB) * VP; bf16x8 vf[4]; \
        _Pragma("unroll") for (int s = 0; s < 2; ++s) { vf[2 * s] = AT_VTR(va_ + 16 * s * VP); vf[2 * s + 1] = AT_VTR(va_ + 16 * s * VP + 64); } \
        if (kb_ + 63 > wq0) {     \
            _Pragma("unroll") for (int i = 0; i < 16; ++i) { const int kk = kb_ + (i & 7) + 8 * h + 16 * (i >> 3); \
                if (kk > q) P0[i] = -1e30f; if (kk + 32 > q) P1[i] = -1e30f; } } \
        float mxa = fmaxf(fmaxf(P0[0], P1[0]), P0[1]), mxb = fmaxf(fmaxf(P0[4], P1[4]), P0[5]), mxc = fmaxf(fmaxf(P0[8], P1[8]), P0[9]), mxd = fmaxf(fmaxf(P0[12], P1[12]), P0[13]); \
        mxa = fmaxf(fmaxf(mxa, P1[1]), P0[2]); mxb = fmaxf(fmaxf(mxb, P1[5]), P0[6]); mxc = fmaxf(fmaxf(mxc, P1[9]), P0[10]); mxd = fmaxf(fmaxf(mxd, P1[13]), P0[14]); \
        mxa = fmaxf(fmaxf(mxa, P1[2]), P0[3]); mxb = fmaxf(fmaxf(mxb, P1[6]), P0[7]); mxc = fmaxf(fmaxf(mxc, P1[10]), P0[11]); mxd = fmaxf(fmaxf(mxd, P1[14]), P0[15]); \
        mxa = fmaxf(fmaxf(mxa, P1[3]), mxb); mxc = fmaxf(fmaxf(mxc, P1[7]), mxd); float mx = fmaxf(fmaxf(mxa, P1[11]), fmaxf(mxc, P1[15])); \
        { const auto rr_ = __builtin_amdgcn_permlane32_swap(__float_as_uint(mx), __float_as_uint(mx), false, false); mx = fmaxf(__uint_as_float(rr_[0]), __uint_as_float(rr_[1])); } \
        if (first || __any(mx > THR)) { \
            const float dl = first ? mx : fmaxf(mx, 0.f); m_ref += dl; \
            if (!first) { const float alpha = __builtin_amdgcn_exp2f(-dl); l_run *= alpha; o0 *= alpha; o1 *= alpha; } \
            _Pragma("unroll") for (int i = 0; i < 16; ++i) { P0[i] -= dl; P1[i] -= dl; } \
            if (ADJ) { _Pragma("unroll") for (int i = 0; i < 16; ++i) { OTH0[i] -= dl; OTH1[i] -= dl; } } \
            first = false; } \
        float ls0 = 0.f, ls1 = 0.f, ls2 = 0.f, ls3 = 0.f; \
        _Pragma("unroll") for (int i = 0; i < 16; i += 4) { \
            P0[i] = __builtin_amdgcn_exp2f(P0[i]); P1[i] = __builtin_amdgcn_exp2f(P1[i]); P0[i + 1] = __builtin_amdgcn_exp2f(P0[i + 1]); P1[i + 1] = __builtin_amdgcn_exp2f(P1[i + 1]); \
            P0[i + 2] = __builtin_amdgcn_exp2f(P0[i + 2]); P1[i + 2] = __builtin_amdgcn_exp2f(P1[i + 2]); P0[i + 3] = __builtin_amdgcn_exp2f(P0[i + 3]); P1[i + 3] = __builtin_amdgcn_exp2f(P1[i + 3]); \
            ls0 += P0[i] + P1[i]; ls1 += P0[i + 1] + P1[i + 1]; ls2 += P0[i + 2] + P1[i + 2]; ls3 += P0[i + 3] + P1[i + 3]; } \
        l_run += (ls0 + ls1) + (ls2 + ls3); \
        u32x4 w0, w1, w2, w3; \
        w0.x = cvtpk(P0[0], P0[1]); w0.y = cvtpk(P0[2], P0[3]); w0.z = cvtpk(P0[4], P0[5]); w0.w = cvtpk(P0[6], P0[7]); \
        w1.x = cvtpk(P0[8], P0[9]); w1.y = cvtpk(P0[10], P0[11]); w1.z = cvtpk(P0[12], P0[13]); w1.w = cvtpk(P0[14], P0[15]); \
        w2.x = cvtpk(P1[0], P1[1]); w2.y = cvtpk(P1[2], P1[3]); w2.z = cvtpk(P1[4], P1[5]); w2.w = cvtpk(P1[6], P1[7]); \
        w3.x = cvtpk(P1[8], P1[9]); w3.y = cvtpk(P1[10], P1[11]); w3.z = cvtpk(P1[12], P1[13]); w3.w = cvtpk(P1[14], P1[15]); \
        const bf16x8 pf0 = __builtin_bit_cast(bf16x8, w0), pf1 = __builtin_bit_cast(bf16x8, w1), pf2 = __builtin_bit_cast(bf16x8, w2), pf3 = __builtin_bit_cast(bf16x8, w3); \
        \
        o0 = __builtin_amdgcn_mfma_f32_32x32x16_bf16(vf[0], pf0, o0, 0, 0, 0); o1 = __builtin_amdgcn_mfma_f32_32x32x16_bf16(vf[1], pf0, o1, 0, 0, 0); \
        o0 = __builtin_amdgcn_mfma_f32_32x32x16_bf16(vf[2], pf1, o0, 0, 0, 0); o1 = __builtin_amdgcn_mfma_f32_32x32x16_bf16(vf[3], pf1, o1, 0, 0, 0); \
        _Pragma("unroll") for (int s = 0; s < 2; ++s) { vf[2 * s] = AT_VTR(va_ + 16 * (s + 2) * VP); vf[2 * s + 1] = AT_VTR(va_ + 16 * (s + 2) * VP + 64); } \
        \
        o0 = __builtin_amdgcn_mfma_f32_32x32x16_bf16(vf[0], pf2, o0, 0, 0, 0); o1 = __builtin_amdgcn_mfma_f32_32x32x16_bf16(vf[1], pf2, o1, 0, 0, 0); \
        o0 = __builtin_amdgcn_mfma_f32_32x32x16_bf16(vf[2], pf3, o0, 0, 0, 0); o1 = __builtin_amdgcn_mfma_f32_32x32x16_bf16(vf[3], pf3, o1, 0, 0, 0); \
        } while (0)
    for (int t = t_lo; t <= t_hi; ++t) {
        if (t < t_hi) { AT_WRITE(lds + ((t + 1) & 1) * BUFSZ); if (t + 1 < t_hi) AT_ISSUE(t + 2); }
        if (t == t_hi && has_next) AT_ISSUE_NEXT();
        const LAS unsigned char* buf = lds + (t & 1) * BUFSZ;
        const int kbA = 128 * t, kbB = kbA + 64;
        const bool actA = (kbA <= wq0 + 31);
        const bool actB = (kbB <= wq0 + 31);
        f32x16 pA0, pA1, pB0, pB1;
        if (actA && actB) {
            AT_S(pA0, pA1, 0); AT_S(pB0, pB1, 1);
            AT_SM(pA0, pA1, 0, true, pB0, pB1);
            AT_SM(pB0, pB1, 1, false, pA0, pA1);
        } else if (actA) {
            AT_S(pA0, pA1, 0); AT_SM(pA0, pA1, 0, false, pB0, pB1);
        } else if (actB) {
            AT_S(pB0, pB1, 1); AT_SM(pB0, pB1, 1, false, pA0, pA1);
        }
        __syncthreads();
    }
#undef AT_ISSUE
#undef AT_ISSUE_NEXT
#undef AT_WRITE
#undef AT_S
#undef AT_SM
    const float l_tot = l_run + __shfl_xor(l_run, 32);
    const float inv = 1.f / l_tot;
    bf16_t* orow = Op + (long)q * opitch;
    store_o_row(orow, o0, o1, inv, h);
    if (MODE == 2 && h == 0) *(GAS float*)(lsep + (long)q * lsepitch) = m_ref + __log2f(l_tot);
}

DI void dil_decode(int L, const bf16_t* QKVC, size_t& qoff, size_t& koff, size_t& voff, size_t& lseoff, int& lsepitch, int& q0) {
    const int j = L & 15, g3 = (L >> 4) % 3, rest = (L >> 4) / 3, hd = rest & 15, bl = rest >> 4;
    const int d = (g3 == 0) ? 1 : (g3 == 1) ? 4 : 16;
    const int res = (g3 == 0) ? 0 : (g3 == 1) ? (j >> 2) : j;
    const int qb = (g3 == 0) ? j : (g3 == 1) ? (j & 3) : 0;
    const size_t prow = (size_t)res * (SEQ / d);
    qoff = ((size_t)(((bl * 3 + 0) * 3 + g3) * 16 + hd) * 4096 + prow) * 64;
    koff = ((size_t)(((bl * 3 + 1) * 3 + g3) * 16 + hd) * 4096 + prow) * 64;
    voff = ((size_t)(((bl * 3 + 2) * 3 + g3) * 16 + hd) * 4096 + prow) * 64;
    lseoff = ((size_t)bl * SEQ + res) * 48 + g3 * 16 + hd; lsepitch = d * 48; q0 = qb * 256;
}
DI void dil_phase(LAS unsigned char* lds, bf16_t* QKVC, float* LSE, int bx, int G) {
    constexpr int KP = 144, VP = 192, VT_OFF = 384 * KP, W = 128;
    constexpr float THR = 8.f;
    const int tid = otid(), lane = tid & 63, r = lane & 31, h = lane >> 5;
    const int wid = __builtin_amdgcn_readfirstlane(tid >> 6);
    const int lkey = tid >> 3, lch = tid & 7;
    const int pr = (r & 19) | ((r & 4) << 1) | ((r & 8) >> 1);
    const int vtr_base = (8 * h + ((lane & 15) >> 2)) * VP + (16 * ((lane >> 4) & 1) + 4 * (lane & 3)) * 2;
    u32x4 kreg[6], vreg[6]; bf16x8 qn[4];
    int L = bx; if (L >= 3072) return;
    size_t qoff, koff, voff, lseoff; int lsepitch, q0;
    dil_decode(L, QKVC, qoff, koff, voff, lseoff, lsepitch, q0);
#define DL_ISSUE(QO, KO, VO, Q0) do { const int kbase_ = ((Q0) == 0) ? 0 : (Q0) - 128; \
        _Pragma("unroll") for (int j = 0; j < 6; ++j) if (j < 4 || (Q0) != 0) { \
            kreg[j] = *(const GAS u32x4*)(QKVC + (KO) + (size_t)(kbase_ + lkey + 64 * j) * 64 + lch * 8); \
            vreg[j] = *(const GAS u32x4*)(QKVC + (VO) + (size_t)(kbase_ + lkey + 64 * j) * 64 + lch * 8); } \
        _Pragma("unroll") for (int s = 0; s < 4; ++s) qn[s] = *(const GAS bf16x8*)(QKVC + (QO) + (size_t)((Q0) + 32 * wid + r) * 64 + 16 * s + 8 * h); } while (0)
    DL_ISSUE(qoff, koff, voff, q0);
    for (;;) {
        const int nj = (q0 == 0) ? 4 : 6, kbase = (q0 == 0) ? 0 : q0 - 128;
#pragma unroll
        for (int j = 0; j < 6; ++j) if (j < nj) {
            *(LAS u32x4*)(lds + (lkey + 64 * j) * KP + lch * 16) = kreg[j];
            *(LAS u32x4*)(lds + VT_OFF + (lkey + 64 * j) * VP + lch * 16) = vreg[j];
        }
        bf16x8 qf[4];
#pragma unroll
        for (int s = 0; s < 4; ++s) qf[s] = qn[s];
        __syncthreads();
        const int Ln = L + G; const bool has_next = Ln < 3072;
        size_t nqoff = 0, nkoff = 0, nvoff = 0, nlseoff = 0; int nlsepitch = 0, nq0 = 0;
        if (has_next) { dil_decode(Ln, QKVC, nqoff, nkoff, nvoff, nlseoff, nlsepitch, nq0); DL_ISSUE(nqoff, nkoff, nvoff, nq0); }
        const int wq0 = q0 + 32 * wid, q = wq0 + r;
        f32x16 o0, o1;
#pragma unroll
        for (int i = 0; i < 16; ++i) { o0[i] = 0.f; o1[i] = 0.f; }
        float m_ref = 0.f, l_run = 0.f; bool first = true;
        int u_lo = (wq0 - W - kbase) >> 6; if (u_lo < 0) u_lo = 0;
        int u_hi = (wq0 + 31 - kbase) >> 6; if (u_hi > nj - 1) u_hi = nj - 1;
        for (int u = u_lo; u <= u_hi; ++u) {
            const int kb = kbase + 64 * u;
            const LAS unsigned char* ka = lds + (64 * u + pr) * KP + h * 16;
            bf16x8 kf[8];
#pragma unroll
            for (int s = 0; s < 4; ++s) { kf[2 * s] = *(const LAS bf16x8*)(ka + s * 32); kf[2 * s + 1] = *(const LAS bf16x8*)(ka + 32 * KP + s * 32); }
            f32x16 p0, p1;
#pragma unroll
            for (int i = 0; i < 16; ++i) { p0[i] = -m_ref; p1[i] = -m_ref; }
#pragma unroll
            for (int s = 0; s < 4; ++s) {
                p0 = __builtin_amdgcn_mfma_f32_32x32x16_bf16(kf[2 * s], qf[s], p0, 0, 0, 0);
                p1 = __builtin_amdgcn_mfma_f32_32x32x16_bf16(kf[2 * s + 1], qf[s], p1, 0, 0, 0);
            }
            const LAS unsigned char* va = lds + VT_OFF + vtr_base + 64 * u * VP; bf16x8 vf[8];
#pragma unroll
            for (int s = 0; s < 4; ++s) { vf[2 * s] = vtr8(va + 16 * s * VP, 4 * VP); vf[2 * s + 1] = vtr8(va + 16 * s * VP + 64, 4 * VP); }
            if ((kb + 63 > wq0) || (kb < wq0 + 31 - W)) {
#pragma unroll
                for (int i = 0; i < 16; ++i) { const int kk = kb + (i & 7) + 8 * h + 16 * (i >> 3);
                    if (kk > q || kk < q - W) p0[i] = -1e30f; if (kk + 32 > q || kk + 32 < q - W) p1[i] = -1e30f; }
            }
            float mxa = fmaxf(fmaxf(p0[0], p1[0]), p0[1]), mxb = fmaxf(fmaxf(p0[4], p1[4]), p0[5]), mxc = fmaxf(fmaxf(p0[8], p1[8]), p0[9]), mxd = fmaxf(fmaxf(p0[12], p1[12]), p0[13]);
            mxa = fmaxf(fmaxf(mxa, p1[1]), p0[2]); mxb = fmaxf(fmaxf(mxb, p1[5]), p0[6]); mxc = fmaxf(fmaxf(mxc, p1[9]), p0[10]); mxd = fmaxf(fmaxf(mxd, p1[13]), p0[14]);
            mxa = fmaxf(fmaxf(mxa, p1[2]), p0[3]); mxb = fmaxf(fmaxf(mxb, p1[6]), p0[7]); mxc = fmaxf(fmaxf(mxc, p1[10]), p0[11]); mxd = fmaxf(fmaxf(mxd, p1[14]), p0[15]);
            mxa = fmaxf(fmaxf(mxa, p1[3]), mxb); mxc = fmaxf(fmaxf(mxc, p1[7]), mxd); float mx = fmaxf(fmaxf(mxa, p1[11]), fmaxf(mxc, p1[15]));
            { const auto rr_ = __builtin_amdgcn_permlane32_swap(__float_as_uint(mx), __float_as_uint(mx), false, false); mx = fmaxf(__uint_as_float(rr_[0]), __uint_as_float(rr_[1])); }
            if (first || __any(mx > THR)) {
                const float dl = first ? mx : fmaxf(mx, 0.f); m_ref += dl;
                if (!first) { const float alpha = __builtin_amdgcn_exp2f(-dl); l_run *= alpha; o0 *= alpha; o1 *= alpha; }
#pragma unroll
                for (int i = 0; i < 16; ++i) { p0[i] -= dl; p1[i] -= dl; }
                first = false;
            }
            float ls0 = 0.f, ls1 = 0.f, ls2 = 0.f, ls3 = 0.f;
#pragma unroll
            for (int i = 0; i < 16; i += 4) {
                p0[i] = __builtin_amdgcn_exp2f(p0[i]); p1[i] = __builtin_amdgcn_exp2f(p1[i]); p0[i + 1] = __builtin_amdgcn_exp2f(p0[i + 1]); p1[i + 1] = __builtin_amdgcn_exp2f(p1[i + 1]);
                p0[i + 2] = __builtin_amdgcn_exp2f(p0[i + 2]); p1[i + 2] = __builtin_amdgcn_exp2f(p1[i + 2]); p0[i + 3] = __builtin_amdgcn_exp2f(p0[i + 3]); p1[i + 3] = __builtin_amdgcn_exp2f(p1[i + 3]);
                ls0 += p0[i] + p1[i]; ls1 += p0[i + 1] + p1[i + 1]; ls2 += p0[i + 2] + p1[i + 2]; ls3 += p0[i + 3] + p1[i + 3]; }
            l_run += (ls0 + ls1) + (ls2 + ls3);
            u32x4 w0, w1, w2, w3;
            w0.x = cvtpk(p0[0], p0[1]); w0.y = cvtpk(p0[2], p0[3]); w0.z = cvtpk(p0[4], p0[5]); w0.w = cvtpk(p0[6], p0[7]);
            w1.x = cvtpk(p0[8], p0[9]); w1.y = cvtpk(p0[10], p0[11]); w1.z = cvtpk(p0[12], p0[13]); w1.w = cvtpk(p0[14], p0[15]);
            w2.x = cvtpk(p1[0], p1[1]); w2.y = cvtpk(p1[2], p1[3]); w2.z = cvtpk(p1[4], p1[5]); w2.w = cvtpk(p1[6], p1[7]);
            w3.x = cvtpk(p1[8], p1[9]); w3.y = cvtpk(p1[10], p1[11]); w3.z = cvtpk(p1[12], p1[13]); w3.w = cvtpk(p1[14], p1[15]);
            const bf16x8 pf0 = __builtin_bit_cast(bf16x8, w0), pf1 = __builtin_bit_cast(bf16x8, w1), pf2 = __builtin_bit_cast(bf16x8, w2), pf3 = __builtin_bit_cast(bf16x8, w3);
            o0 = __builtin_amdgcn_mfma_f32_32x32x16_bf16(vf[0], pf0, o0, 0, 0, 0); o1 = __builtin_amdgcn_mfma_f32_32x32x16_bf16(vf[1], pf0, o1, 0, 0, 0);
            o0 = __builtin_amdgcn_mfma_f32_32x32x16_bf16(vf[2], pf1, o0, 0, 0, 0); o1 = __builtin_amdgcn_mfma_f32_32x32x16_bf16(vf[3], pf1, o1, 0, 0, 0);
            o0 = __builtin_amdgcn_mfma_f32_32x32x16_bf16(vf[4], pf2, o0, 0, 0, 0); o1 = __builtin_amdgcn_mfma_f32_32x32x16_bf16(vf[5], pf2, o1, 0, 0, 0);
            o0 = __builtin_amdgcn_mfma_f32_32x32x16_bf16(vf[6], pf3, o0, 0, 0, 0); o1 = __builtin_amdgcn_mfma_f32_32x32x16_bf16(vf[7], pf3, o1, 0, 0, 0);
        }
        const float l_tot = l_run + __shfl_xor(l_run, 32);
        const float inv = 1.f / l_tot;
        bf16_t* orow = QKVC + qoff + (size_t)q * 64;
        store_o_row(orow, o0, o1, inv, h);
        if (h == 0) *(GAS float*)(LSE + lseoff + (size_t)q * lsepitch) = m_ref + __log2f(l_tot);
        __syncthreads();
        if (!has_next) break;
        L = Ln; qoff = nqoff; koff = nkoff; voff = nvoff; lseoff = nlseoff; lsepitch = nlsepitch; q0 = nq0;
    }
#undef DL_ISSUE
}

DI void sincos_acc(float ang, float& s, float& c) {
    const double x = (double)ang;
    const double k = __builtin_rint(x * 0.63661977236758134);
    double rr = __builtin_fma(-k, 1.5707963267948966, x); rr = __builtin_fma(-k, 6.123233995736766e-17, rr);
    const int qd = ((int)k) & 3;
    const double r2 = rr * rr;
    const double sp = rr * (1.0 + r2 * (-1.0 / 6 + r2 * (1.0 / 120 + r2 * (-1.0 / 5040 + r2 * (1.0 / 362880 + r2 * (-1.0 / 39916800 + r2 * (1.0 / 6227020800.0)))))));
    const double cp = 1.0 + r2 * (-0.5 + r2 * (1.0 / 24 + r2 * (-1.0 / 720 + r2 * (1.0 / 40320 + r2 * (-1.0 / 3628800 + r2 * (1.0 / 479001600 + r2 * (-1.0 / 87178291200.0)))))));
    const double sv = (qd == 0) ? sp : (qd == 1) ? cp : (qd == 2) ? -sp : -cp;
    const double cv = (qd == 0) ? cp : (qd == 1) ? -sp : (qd == 2) ? -cp : sp;
    s = (float)sv; c = (float)cv;
}
DI int perm_dil(int l) { return (l & ~63) | (((l >> 4) & 1) << 5) | (((l >> 2) & 3) << 3) | (((l >> 5) & 1) << 2) | (l & 3); }
DI int perm_r32(int l) { return (l & ~31) | (((l >> 2) & 3) << 3) | (((l >> 4) & 1) << 2) | (l & 3); }
DI void cvt_item(const float* W, int ldw, int col0, int ncols, int K, const float* gain, bf16_t* WT, int row_off, int mode, LAS float* scr, int item, int lane) {
    const int nblk = (ncols + 31) >> 5, kb = item / nblk, nb = item - kb * nblk, k0 = 64 * kb, n0 = 32 * nb;
    const int nn = n0 + (lane & 31); const bool ok = nn < ncols;
#pragma unroll
    for (int i = 0; i < 32; ++i) { const int kk = 2 * i + (lane >> 5); float w = ok ? *(const GAS float*)(W + (size_t)(k0 + kk) * ldw + col0 + nn) : 0.f; if (gain) w *= *(const GAS float*)(gain + k0 + kk); scr[kk * 33 + (lane & 31)] = w; }
    asm volatile("s_waitcnt lgkmcnt(0)" ::: "memory");
    const int c = lane & 7;
#pragma unroll
    for (int j = 0; j < 4; ++j) { const int n = (lane >> 3) + 8 * j, nsrc = n0 + n; const LAS float* s = scr + (8 * c) * 33 + n;
        if (nsrc < ncols) { const int ndst = (mode == 1 && nsrc < 6144) ? perm_dil(nsrc) : (mode == 2 && ((nsrc >> 5) % 3) == 2) ? perm_r32(nsrc) : (mode == 3) ? perm_r32(nsrc) : nsrc;
            u32x4 o; o.x = cvtpk(s[0 * 33], s[1 * 33]); o.y = cvtpk(s[2 * 33], s[3 * 33]); o.z = cvtpk(s[4 * 33], s[5 * 33]); o.w = cvtpk(s[6 * 33], s[7 * 33]);
            *(GAS u32x4*)(WT + (size_t)(row_off + ndst) * K + k0 + 8 * c) = o; } }
    asm volatile("s_waitcnt lgkmcnt(0)" ::: "memory");
}
DI void cvt_job(const float* W, int ldw, int col0, int ncols, int K, const float* gain, bf16_t* WT, int row_off, int mode, LAS float* scr, int gw, int NGW, int lane) {
    const int items = (K >> 6) * ((ncols + 31) >> 5);
    for (int it = gw; it < items; it += NGW) cvt_item(W, ldw, col0, ncols, K, gain, WT, row_off, mode, scr, it, lane);
}
DI void zero_rows(bf16_t* p, size_t nelem, int gt, int NGT) {
    const u32x4 z = {0, 0, 0, 0};
    for (size_t i = (size_t)gt * 8; i < nelem; i += (size_t)NGT * 8) *(GAS u32x4*)(p + i) = z;
}

#define XB_TMO      128
#define XB_XCNT(j)  (256  + 64 * (j))
#define XB_XSUB(j)  (1280 + 64 * (j))
#define XB_XGEN(j)  (2304 + 64 * (j))
#define XB_TOP      3328
#define XB_TOPGEN   3392
#define XCD_BAR_WORDS 3456
#define XB_SPIN_CAP (1u << 18)

__device__ __forceinline__ unsigned xb_ld(unsigned* p)              { return __hip_atomic_load(p, __ATOMIC_RELAXED, __HIP_MEMORY_SCOPE_AGENT); }
__device__ __forceinline__ unsigned xb_add(unsigned* p, unsigned v) { return __hip_atomic_fetch_add(p, v, __ATOMIC_RELAXED, __HIP_MEMORY_SCOPE_AGENT); }
__device__ __forceinline__ unsigned xb_xcc_id() { return (unsigned)__builtin_amdgcn_s_getreg((3 << 11) | 20) & 0xFu; }
#define XB_SPIN(cond, bar) do { unsigned _sp = 0; while (cond) { __builtin_amdgcn_s_sleep(1); \
    if ((++_sp & 255u) == 0u) { if (xb_ld(&(bar)[XB_TMO])) break; if (_sp > XB_SPIN_CAP) { atomicAdd(&(bar)[XB_TMO], 1u); break; } } } } while (0)

struct XcdBarrier {
    unsigned* bar; unsigned x;
    volatile LAS unsigned* st;
};

__device__ __forceinline__ XcdBarrier xcd_barrier_post(unsigned* bar, volatile LAS unsigned* st) {
    XcdBarrier b; b.bar = bar; b.x = xb_xcc_id(); b.st = st;
    if (threadIdx.x == 0) (void)xb_add(&bar[XB_XCNT(b.x)], 1u);
    return b;
}
__device__ __forceinline__ void xcd_barrier_complete(unsigned* bar, unsigned x, unsigned& nloc, unsigned& nx) {
    const unsigned G = gridDim.x * gridDim.y * gridDim.z;
    unsigned sum, cnt, mine, sp = 0u;
    for (;;) {
        sum = 0u; cnt = 0u; mine = 0u;
#pragma unroll
        for (unsigned j = 0; j < 16; ++j) { const unsigned c = xb_ld(&bar[XB_XCNT(j)]); sum += c; cnt += (c > 0u) ? 1u : 0u; mine = (j == x) ? c : mine; }
        if (sum == G) break;
        __builtin_amdgcn_s_sleep(1);
        if ((++sp & 255u) == 0u) { if (xb_ld(&bar[XB_TMO])) break; if (sp > XB_SPIN_CAP) { atomicAdd(&bar[XB_TMO], 1u); break; } }
    }
    nloc = mine > 0u ? mine : 1u; nx = cnt > 0u ? cnt : 1u;
}

__device__ __forceinline__ void xcd_barrier(const XcdBarrier& b) {
    asm volatile("s_waitcnt vmcnt(0)" ::: "memory");
    __syncthreads();
    if (threadIdx.x == 0) {
        unsigned* bar = b.bar;
        __builtin_amdgcn_s_waitcnt(0);
        unsigned nloc = b.st[0], nx = b.st[1];
        if (nloc == 0u) { xcd_barrier_complete(bar, b.x, nloc, nx); b.st[0] = nloc; b.st[1] = nx; }
        const unsigned old = xb_add(&bar[XB_XSUB(b.x)], 1u);
        const unsigned gen = old / nloc;
        if (old + 1u == (gen + 1u) * nloc) {
            __builtin_amdgcn_fence(__ATOMIC_RELEASE, "agent");
            asm volatile("s_waitcnt vmcnt(0)" ::: "memory");
            const unsigned og = xb_add(&bar[XB_TOP], 1u);
            const unsigned tg = og / nx;
            if (og + 1u == (tg + 1u) * nx) xb_add(&bar[XB_TOPGEN], 1u);
            else XB_SPIN(xb_ld(&bar[XB_TOPGEN]) == tg, bar);
            __builtin_amdgcn_fence(__ATOMIC_ACQUIRE, "agent");
            xb_add(&bar[XB_XGEN(b.x)], 1u);
            asm volatile("s_waitcnt vmcnt(0)" ::: "memory");
        } else {
            XB_SPIN(xb_ld(&bar[XB_XGEN(b.x)]) == gen, bar);
            __builtin_amdgcn_fence(__ATOMIC_ACQUIRE, "agent");
            asm volatile("s_waitcnt vmcnt(0)" ::: "memory");
        }
    }
    __syncthreads();
}

DI const float* ldarg(int idx) {
    const float* p; const int off = __builtin_amdgcn_readfirstlane(idx * 8);
    asm volatile("s_load_dwordx2 %0, %1, %2\n\ts_waitcnt lgkmcnt(0)" : "=s"(p) : "s"(__builtin_amdgcn_kernarg_segment_ptr()), "s"(off) : "memory");
    return p;
}
DI void cvt_layer(int layer, bf16_t* WB, u64* SQ, u64* SKV, LAS float* scr, int gw, int NGW, int gt, int NGT, int lane) {
    const int kind = (layer == 3) ? 0 : layer;
    const int b0 = layer == 0 ? 1 : layer == 1 ? 12 : layer == 2 ? 20 : 26;
    for (int i = gt; i < T_TOK; i += NGT) { st_dev(SQ + i, 0.f); st_dev(SKV + i, 0.f); }
    const float* attn_norm = ldarg(b0);
    const int bw = b0 + (kind == 0 ? 7 : kind == 1 ? 4 : 2);
    const float* w_o = ldarg(bw); const float* mlp_norm = ldarg(bw + 1); const float* w_up = ldarg(bw + 2); const float* w_down = ldarg(bw + 3);
#define CJ(W_, ldw_, col0_, ncols_, K_, gain_, WT_, roff_, mode_) { const int n_ = ((K_) >> 6) * (((ncols_) + 31) >> 5); \
        if (r_ < n_) { cvt_item(W_, ldw_, col0_, ncols_, K_, gain_, WT_, roff_, mode_, scr, r_, lane); continue; } r_ -= n_; }
#define CJ_MLP CJ(w_up, 4096, 0, 4096, 1024, mlp_norm, WB + WO_UP, 0, 0) CJ(w_down, 1024, 0, 1024, 4096, nullptr, WB + WO_DOWN, 0, 0) CJ(w_o, 1024, 0, 1024, 1024, nullptr, WB + WO_WO, 0, 0)
    if (kind == 0) {
        const float* wq_a = ldarg(b0 + 1); const float* wkv_a = ldarg(b0 + 4);
        const float* q_norm = ldarg(b0 + 2); const float* wq_b = ldarg(b0 + 3); const float* kv_norm = ldarg(b0 + 5); const float* wkv_b = ldarg(b0 + 6);
        zero_rows(WB + WO_MIX + (size_t)672 * 1024, (size_t)96 * 1024, gt, NGT);
        for (int it = gw; it < 2048 + 2048 + 512 + 128 + 192 + 16 + 288 + 256; it += NGW) { int r_ = it;
            CJ_MLP
            CJ(wkv_a, 288, 0, 256, 1024, attn_norm, WB + WO_MIX, 0, 0) CJ(wq_a, 384, 0, 384, 1024, attn_norm, WB + WO_MIX, 256, 0) CJ(wkv_a, 288, 256, 32, 1024, attn_norm, WB + WO_MIX, 640, 3)
            CJ(wq_b, 1536, 0, 1536, 384, q_norm, WB + WO_QB, 0, 2) CJ(wkv_b, 2048, 0, 2048, 256, kv_norm, WB + WO_KVB, 0, 0) }
    } else if (kind == 1) {
        const float* w_qkv = ldarg(13); const float* w_f = ldarg(14);
        zero_rows(WB + WO_MIX + (size_t)3088 * 1024, (size_t)240 * 1024, gt, NGT);
        for (int it = gw; it < 2048 + 2048 + 512 + 1536 + 16; it += NGW) { int r_ = it;
            CJ_MLP
            CJ(w_qkv, 3072, 0, 3072, 1024, attn_norm, WB + WO_MIX, 0, 0) CJ(w_f, 16, 0, 16, 1024, attn_norm, WB + WO_MIX, 3072, 0) }
    } else {
        const float* w_qkv = ldarg(21);
        for (int it = gw; it < 2048 + 2048 + 512 + 4608; it += NGW) { int r_ = it;
            CJ_MLP
            CJ(w_qkv, 9216, 0, 9216, 1024, attn_norm, WB + WO_MIX, 0, 1) }
    }
#undef CJ
#undef CJ_MLP
}
struct Params { const float* in[38]; float* out; unsigned char* ws; int lo, hi; };

__global__ void __launch_bounds__(512) mega(Params P) {
    extern __shared__ __attribute__((aligned(16))) unsigned char lds_raw[];
    LAS unsigned char* lds = (LAS unsigned char*)lds_raw;
    cg::grid_group grid = cg::this_grid();
    { volatile LAS unsigned* st_ = (volatile LAS unsigned*)(lds + LDS_BYTES - 64); if (threadIdx.x < 2) st_[threadIdx.x] = 0u; }
    __syncthreads();
    XcdBarrier xbar; xbar.bar = (unsigned*)P.ws; xbar.x = 0; xbar.st = (volatile LAS unsigned*)(lds + LDS_BYTES - 64);
    const int G = gridDim.x, NGW = G * 8, NGT = G * 512;
#define IDS const int tid = otid(), lane = tid & 63, wave = __builtin_amdgcn_readfirstlane(tid >> 6), bx = obid(), gw = bx * 8 + wave, gt = bx * 512 + tid; LAS float* scr = (LAS float*)(lds + wave * 16384); (void)lane; (void)gw; (void)gt; (void)scr; \
    unsigned char* ws = P.ws; asm volatile("" : "+s"(ws)); float* H = P.out; asm volatile("" : "+s"(H)); bf16_t* HL = (bf16_t*)H; (void)HL; \
    float* cosM = (float*)(ws + WS_COSM); float* sinM = (float*)(ws + WS_SINM); float* cosD = (float*)(ws + WS_COSD); float* sinD = (float*)(ws + WS_SIND); \
    u64* SSA = (u64*)(ws + WS_P16); u64* SSB = SSA + T_TOK; u64* SQ = SSB + T_TOK; u64* SKV = SQ + T_TOK; \
    bf16_t* WB0 = (bf16_t*)(ws + WS_W); bf16_t* WB1 = (bf16_t*)(ws + WS_W1); bf16_t* HB = (bf16_t*)(ws + WS_HB); unsigned char* R = ws + WS_R; \
    float* LOGF = (float*)(ws + WS_LOGF); float* DLB = (float*)(ws + WS_DL); bf16_t* KPE = (bf16_t*)(ws + WS_KPE); float* LSE = (float*)(ws + WS_LSE); \
    (void)H; (void)cosM; (void)sinM; (void)cosD; (void)sinD; (void)SSA; (void)SSB; (void)SQ; (void)SKV; (void)WB0; (void)WB1; (void)HB; (void)R; (void)LOGF; (void)DLB; (void)KPE; (void)LSE
    const int lo = P.lo, hi = P.hi;
    int ph = 0;
#define PH_ON (ph >= lo && ph < hi)
#define PH_END do { if (ph >= lo && ph + 1 < hi) { if (ph == 0) { grid.sync(); xbar = xcd_barrier_post((unsigned*)P.ws, (volatile LAS unsigned*)(lds + LDS_BYTES - 64)); } else xcd_barrier(xbar); } ++ph; } while (0)

    if (PH_ON) { IDS;
        if (bx == 0) for (int i = tid; i < 4096; i += 512) __hip_atomic_store((unsigned*)ws + i, 0u, __ATOMIC_RELAXED, __HIP_MEMORY_SCOPE_AGENT);
        for (int i = gt; i < SEQ * 16; i += NGT) { const int pos = i >> 4, f = i & 15; float s, c; sincos_acc((float)pos * INV16[f], s, c); *(GAS float*)(cosM + i) = c; *(GAS float*)(sinM + i) = s; }
        for (int i = gt; i < SEQ * 32; i += NGT) { const int pos = i >> 5, f = i & 31; float s, c; sincos_acc((float)pos * INV32[f], s, c); *(GAS float*)(cosD + i) = c; *(GAS float*)(sinD + i) = s; }
        const float* x = ldarg(0);
        for (int row = gw; row < T_TOK; row += NGW) {
            const GAS f32x4* xr = (const GAS f32x4*)(x + (size_t)row * DM) + lane; float ss = 0.f;
#pragma unroll
            for (int j = 0; j < 4; ++j) { const f32x4 v = xr[64 * j]; ss += dot4(v); u32x2 hh_, ll_; { const u32x2 s0 = split2(v.x, v.y), s1 = split2(v.z, v.w); hh_.x = s0.x; ll_.x = s0.y; hh_.y = s1.x; ll_.y = s1.y; }
                *(GAS u32x2*)(HB + (size_t)row * DM + 4 * lane + 256 * j) = hh_; if (RES_LO) *(GAS u32x2*)(HL + (size_t)row * DM + 4 * lane + 256 * j) = ll_; }
            ss = wave_sum(ss);
            if (lane == 0) { st_dev(SSB + row, ss); st_dev(SSA + row, 0.f); }
        }
        cvt_layer(0, WB0, SQ, SKV, scr, gw, NGW, gt, NGT, lane);
    }
    PH_END;

#pragma nounroll
    for (int layer = 0; layer < 4; ++layer) {
        const int kind = (layer == 3) ? 0 : layer;
#define WB ((layer & 1) ? WB1 : WB0)
#define Obuf ((bf16_t*)(R + (kind == 0 ? R_O_MLA : kind == 1 ? R_O_FOX : R_O_DIL)))
        if (kind == 0) {
#define CKV ((bf16_t*)(R + R_CKV))
#define CQ ((bf16_t*)(R + R_CQ))
#define Q ((bf16_t*)(R + R_Q))
#define KV ((bf16_t*)(R + R_KV))
            if (PH_ON) { IDS;
                pg8::Gemm g{HB, WB + WO_MIX, T_TOK, 768, 1024}; pg8::StaticOrder S; S.init(T_TOK, 768, G, bx);
                EpiMlaA E{SSB, CKV, CQ, KPE, SQ, SKV, cosM, sinM};
                pg8::gemm_phase<EpiMlaA, pg8::StaticOrder, true, true>(lds, g, S, E);
            }
            PH_END;
            if (PH_ON) { IDS;
                { pg8::Gemm g{CQ, WB + WO_QB, T_TOK, 1536, 384}; pg8::StaticOrder S; S.init(T_TOK, 1536, G, bx);
                  EpiMlaQ E{SQ, Q, cosM, sinM};
                  pg8::gemm_phase<EpiMlaQ, pg8::StaticOrder, true, true>(lds, g, S, E); }
                __syncthreads();
                { pg8::Gemm g{CKV, WB + WO_KVB, T_TOK, 2048, 256}; pg8::StaticOrder S; S.init(T_TOK, 2048, G, bx);
                  EpiMlaKV E{SKV, KV};
                  pg8::gemm_phase<EpiMlaKV, pg8::StaticOrder, true, true>(lds, g, S, E); }
            }
            PH_END;
            if (PH_ON) { IDS;
                u32x4 kreg0 = {0, 0, 0, 0}, kreg1 = kreg0, k2reg = kreg0, vreg0 = kreg0, vreg1 = kreg0; f32x4 dkreg = {0.f, 0.f, 0.f, 0.f}; bool pre = false;
                for (int L = bx; L < 2048; L += G) {
                    const int slot = 7 - (L >> 8), v = L & 255, bh = ((v >> 4) << 3) | (v & 7), p = (v >> 3) & 1, b = bh >> 4, hh = bh & 15;
                    const int base = 4 * (slot >> 1), qb = (slot & 1) ? base + 3 - p : base + p;
                    const size_t t0 = (size_t)b * SEQ;
                    const int Ln = L + G; const bool has_next = Ln < 2048;
                    const int vn = Ln & 255, bhn = ((vn >> 4) << 3) | (vn & 7); const size_t t0n = (size_t)(bhn >> 4) * SEQ; const int hn = bhn & 15;
                    attn_unit<96, 0>(lds, Q + t0 * 1536 + hh * 96, 1536, KV + t0 * 2048 + hh * 128, 2048, KPE + t0 * 32, 32,
                                     KV + t0 * 2048 + hh * 128 + 64, 2048, Obuf + t0 * 1024 + hh * 64, 1024, nullptr, nullptr, 0, qb * 256, 1 << 20,
                                     pre, has_next, KV + t0n * 2048 + hn * 128, KPE + t0n * 32, KV + t0n * 2048 + hn * 128 + 64, nullptr, kreg0, kreg1, k2reg, vreg0, vreg1, dkreg);
                    pre = has_next;
                }
            }
            PH_END;
        } else if (kind == 1) {
#define QKV ((bf16_t*)(R + R_QKV))
            if (PH_ON) { IDS;
                pg8::Gemm g{HB, WB + WO_MIX, T_TOK, 3328, 1024}; pg8::StaticOrder S; S.init(T_TOK, 3328, G, bx);
                EpiFox E{SSB, QKV, LOGF, ldarg(15)};
                pg8::gemm_phase<EpiFox, pg8::StaticOrder, true, true>(lds, g, S, E);
            }
            PH_END;
            if (PH_ON) { IDS;
                for (int sq = gw; sq < 128; sq += NGW) {
                    const float* src = LOGF + (size_t)(sq >> 4) * SEQ * 16 + (sq & 15) + (size_t)(64 * lane) * 16;
                    float s = 0.f;
                    float lv[64];
#pragma unroll
                    for (int i = 0; i < 64; ++i) lv[i] = *(const GAS float*)(src + i * 16);
#pragma unroll
                    for (int i = 0; i < 64; ++i) s += lv[i];
                    float inc = s;
#pragma unroll
                    for (int o = 1; o < 64; o <<= 1) { const float t = __shfl_up(inc, o); if (lane >= o) inc += t; }
                    float run = inc - s; float* dst = DLB + (size_t)sq * SEQ + 64 * lane;
#pragma unroll
                    for (int i = 0; i < 64; ++i) { run += lv[i]; *(GAS float*)(dst + i) = run * LOG2E; }
                }
            }
            PH_END;
            if (PH_ON) { IDS;
                u32x4 kreg0 = {0, 0, 0, 0}, kreg1 = kreg0, k2reg = kreg0, vreg0 = kreg0, vreg1 = kreg0; f32x4 dkreg = {0.f, 0.f, 0.f, 0.f}; bool pre = false;
                for (int L = bx; L < 2048; L += G) {
                    const int slot = 7 - (L >> 8), v = L & 255, bh = ((v >> 4) << 3) | (v & 7), p = (v >> 3) & 1, b = bh >> 4, hh = bh & 15;
                    const int base = 4 * (slot >> 1), qb = (slot & 1) ? base + 3 - p : base + p;
                    const size_t t0 = (size_t)b * SEQ;
                    const int Ln = L + G; const bool has_next = Ln < 2048;
                    const int vn = Ln & 255, bhn = ((vn >> 4) << 3) | (vn & 7); const size_t t0n = (size_t)(bhn >> 4) * SEQ; const int hn = bhn & 15;
                    attn_unit<64, 1>(lds, QKV + t0 * 3072 + hh * 64, 3072, QKV + t0 * 3072 + 1024 + hh * 64, 3072, nullptr, 0,
                                     QKV + t0 * 3072 + 2048 + hh * 64, 3072, Obuf + t0 * 1024 + hh * 64, 1024, DLB + (size_t)bh * SEQ, nullptr, 0, qb * 256, 1 << 20,
                                     pre, has_next, QKV + t0n * 3072 + 1024 + hn * 64, nullptr, QKV + t0n * 3072 + 2048 + hn * 64, DLB + (size_t)bhn * SEQ, kreg0, kreg1, k2reg, vreg0, vreg1, dkreg);
                    pre = has_next;
                }
            }
            PH_END;
        } else {
#define QKVC ((bf16_t*)(R + R_QKV))
#pragma nounroll
            for (int ch = 0; ch < 2; ++ch) {
                const size_t row0 = (size_t)ch * 16384;
                if (PH_ON) { IDS;
                    pg8::Gemm g{HB + row0 * DM, WB + WO_MIX, 16384, 9216, 1024}; pg8::StaticOrder S; S.init(16384, 9216, G, bx);
                    EpiDil E{SSB + row0, QKVC, cosD, sinD};
                    pg8::gemm_phase<EpiDil, pg8::StaticOrder, true, true>(lds, g, S, E);
                }
                PH_END;
                if (PH_ON) { IDS;
                    dil_phase(lds, QKVC, LSE, bx, G);
                }
                PH_END;
                if (PH_ON) { IDS;
                    for (int i = gt; i < 16384 * 128; i += NGT) {
                        const int tok = i >> 7, c8 = i & 127, hd = c8 >> 3;
                        const GAS float* lp = (const GAS float*)(LSE + (size_t)tok * 48 + hd); const float l0 = lp[0], l1 = lp[16], l2 = lp[32];
                        const float mx = fmaxf(l0, fmaxf(l1, l2));
                        float w0 = __builtin_amdgcn_exp2f(l0 - mx), w1 = __builtin_amdgcn_exp2f(l1 - mx), w2 = __builtin_amdgcn_exp2f(l2 - mx);
                        const float iw = 1.f / (w0 + w1 + w2); w0 *= iw; w1 *= iw; w2 *= iw;
                        const int cbl = tok >> 12, ct = tok & 4095, cch = c8 & 7;
                        const size_t r0 = ct, r1 = ((size_t)(ct & 3) << 10) + (ct >> 2), r2 = ((size_t)(ct & 15) << 8) + (ct >> 4);
                        const bf16_t* pl = QKVC + (size_t)((cbl * 9) * 16 + hd) * 4096 * 64 + cch * 8;
                        const u32x4 a = *(const GAS u32x4*)(pl + r0 * 64), b = *(const GAS u32x4*)(pl + ((size_t)16 * 4096 + r1) * 64), c = *(const GAS u32x4*)(pl + ((size_t)32 * 4096 + r2) * 64);
                        u32x4 o;
#pragma unroll
                        for (int e = 0; e < 4; ++e) {
                            const float alo = __uint_as_float(a[e] << 16), ahi = __uint_as_float(a[e] & 0xffff0000u);
                            const float blo = __uint_as_float(b[e] << 16), bhi = __uint_as_float(b[e] & 0xffff0000u);
                            const float clo = __uint_as_float(c[e] << 16), chi = __uint_as_float(c[e] & 0xffff0000u);
                            o[e] = cvtpk(w0 * alo + w1 * blo + w2 * clo, w0 * ahi + w1 * bhi + w2 * chi);
                        }
                        *(GAS u32x4*)(Obuf + (row0 + tok) * 1024 + c8 * 8) = o;
                    }
                }
                PH_END;
            }
        }
        if (PH_ON) { IDS;
            pg8::Gemm g{Obuf, WB + WO_WO, T_TOK, 1024, 1024}; pg8::StaticOrder S; S.init(T_TOK, 1024, G, bx);
            for (int i = gt; i < T_TOK; i += NGT) st_dev(SSB + i, 0.f);
            EpiRes E{HB, HL, HL, SSA};
            pg8::gemm_phase<EpiRes, pg8::StaticOrder, true, true>(lds, g, S, E);
        }
        PH_END;
        if (PH_ON) { IDS;
            pg8::Gemm g{HB, WB + WO_UP, T_TOK, 4096, 1024}; pg8::StaticOrder S; S.init(T_TOK, 4096, G, bx);
            EpiUp E{SSA, (bf16_t*)(R + R_U)};
            pg8::gemm_phase<EpiUp, pg8::StaticOrder, true, true>(lds, g, S, E);
        }
        PH_END;
        if (PH_ON) { IDS;
            pg8::Gemm g{(const bf16_t*)(R + R_U), WB + WO_DOWN, T_TOK, 1024, 4096}; pg8::StaticOrder S; S.init(T_TOK, 1024, G, bx);
            for (int i = gt; i < T_TOK; i += NGT) st_dev(SSA + i, 0.f);
            if (layer < 3) { cvt_layer(layer + 1, (layer & 1) ? WB0 : WB1, SQ, SKV, scr, gw, NGW, gt, NGT, lane); __syncthreads(); }
            EpiRes E{HB, HL, (layer == 3) ? (bf16_t*)(R + 256 * MiB) : HL, SSB};
            pg8::gemm_phase<EpiRes, pg8::StaticOrder, true, true>(lds, g, S, E);
        }
        PH_END;
    }
    if (PH_ON) { IDS;
        const float* gain = ldarg(37);
        for (int row = gw; row < T_TOK; row += NGW) {
            const float rs = rsqrtf(ld_dev(SSB + row) * (1.f / 1024.f) + EPS);
            const GAS u32x2* hp = (const GAS u32x2*)(HB + (size_t)row * DM) + lane; const GAS u32x2* lp = (const GAS u32x2*)((const bf16_t*)(R + 256 * MiB) + (size_t)row * DM) + lane;
            GAS f32x4* orow = (GAS f32x4*)(H + (size_t)row * DM) + lane; const GAS f32x4* gr = (const GAS f32x4*)gain + lane;
#pragma unroll
            for (int j = 0; j < 4; ++j) { const u32x2 hh_ = hp[64 * j], ll_ = RES_LO ? lp[64 * j] : (u32x2){0u, 0u}; const f32x4 gq = gr[64 * j];
                f32x4 v = {bflo(hh_.x) + bflo(ll_.x), bfhi(hh_.x) + bfhi(ll_.x), bflo(hh_.y) + bflo(ll_.y), bfhi(hh_.y) + bfhi(ll_.y)};
                orow[64 * j] = v * rs * gq; }
        }
    }
    PH_END;
#undef PH_ON
#undef PH_END
}

constexpr int N_PHASES = 1 + 6 + 6 + 9 + 6 + 1;
#ifndef MK_COOP
#define MK_COOP 1
#endif

extern "C" void kernel_launch(void* const* d_in, const int* in_sizes, int n_in, void* d_out, int out_size, void* d_ws, size_t ws_size, hipStream_t stream) {
    static int grid = 0;
    if (grid == 0) {
        if (n_in != 38 || out_size != T_TOK * DM || ws_size < WS_NEED) { fprintf(stderr, "kernel_launch: unexpected shapes (n_in %d out %d ws %zu)\n", n_in, out_size, ws_size); grid = -1; return; }
        int dev = 0, cus = 0, per_cu = 0;
        hipGetDevice(&dev); hipDeviceGetAttribute(&cus, hipDeviceAttributeMultiprocessorCount, dev);
        if (hipFuncSetAttribute((const void*)mega, hipFuncAttributeMaxDynamicSharedMemorySize, LDS_BYTES) != hipSuccess) { fprintf(stderr, "kernel_launch: hipFuncSetAttribute failed\n"); grid = -1; return; }
        if (hipOccupancyMaxActiveBlocksPerMultiprocessor(&per_cu, (const void*)mega, 512, LDS_BYTES) != hipSuccess || per_cu < 1) per_cu = 1;
        (void)hipGetLastError();
        grid = cus * per_cu;
        if (grid <= 0) grid = 256;
    }
    if (grid < 0) return;
    Params p{};
    for (int i = 0; i < 38; ++i) p.in[i] = (const float*)d_in[i];
    p.out = (float*)d_out; p.ws = (unsigned char*)d_ws;
#if MK_COOP
    p.lo = 0; p.hi = N_PHASES;
    void* args[] = {&p};
    hipError_t e = hipLaunchCooperativeKernel((const void*)mega, dim3(grid), dim3(512), args, LDS_BYTES, stream);
    if (e != hipSuccess) fprintf(stderr, "cooperative launch failed: %s (grid %d)\n", hipGetErrorString(e), grid);
#else
    for (int k = 0; k < N_PHASES; ++k) { p.lo = k; p.hi = k + 1; hipLaunchKernelGGL(mega, dim3(grid), dim3(512), LDS_BYTES, stream, p); }
#endif
}
```

```cpp
#include <hip/hip_runtime.h>
#include <hip/hip_cooperative_groups.h>
#include <cstdio>
#include <cstdint>
namespace cg = cooperative_groups;
namespace pg8 {
#define PG8_LAS __attribute__((address_space(3)))
typedef unsigned short bf16_t;
typedef short bf16x8 __attribute__((ext_vector_type(8)));
typedef float f32x4 __attribute__((ext_vector_type(4)));
typedef unsigned u32x4 __attribute__((ext_vector_type(4)));
constexpr int BM = 256, BK = 64, HALF = 128, HTB = HALF * BK * 2  , STAGE_BYTES = 8 * HTB, NXCD = 8, WGM = 8;

__host__ __device__ __forceinline__ int lds_byte(int r, int c) { const int st = (r >> 4) * 2 + (c >> 5), rr = r & 15, cc = c & 31, ob = rr * 64 + cc * 2; return st * 1024 + (ob ^ (((ob >> 9) & 1) << 5)); }
__host__ __device__ __forceinline__ void stage_rc(int b, int& R, int& C) { const int st = b / 1024, sb = b % 1024, swz = sb ^ (((sb >> 9) & 1) << 5); R = (st >> 1) * 16 + swz / 64; C = (st & 1) * 32 + (swz % 64) / 2; }
__host__ __device__ __forceinline__ int perm32(int rho) { const int n = rho >> 4, i = rho & 15; return 8 * (i >> 2) + 4 * n + (i & 3); }

struct Unit { int pm, pn; };
struct Gemm { const bf16_t* A; const bf16_t* Bt; int M, N, K; };

struct StaticOrder {
    int nM, nN, nwg, G, c;
    __host__ __device__ void init(int M, int N, int G_, int c_) { nM = M / BM; nN = N / BM; nwg = nM * nN; G = G_; c = c_; }
    __host__ __device__ bool next(int i, Unit& u) const {
        const long L = (long)i * G + c; if (L >= nwg) return false;
        int wgid = (int)L; { const int q = nwg / NXCD, r = nwg % NXCD, xcd = wgid % NXCD, off = wgid / NXCD; wgid = (xcd < r ? xcd * (q + 1) : r * (q + 1) + (xcd - r) * q) + off; }
        const int nig = WGM * nN, gid = wgid / nig, fm = gid * WGM, gsz = (nM - fm) < WGM ? (nM - fm) : WGM;
        u.pm = fm + ((wgid % nig) % gsz); u.pn = (wgid % nig) / gsz; return true;
    }
    __device__ __forceinline__ void a_ready(const Unit&) const {}
    __device__ __forceinline__ void done(const Unit&) const {}
};
__device__ __forceinline__ unsigned cvt_pk_bf16(float lo, float hi) { unsigned r; asm volatile("v_cvt_pk_bf16_f32 %0, %1, %2" : "=v"(r) : "v"(lo), "v"(hi)); return r; }
template <class Epi, class Sched, bool ALIGN_EPI = false, bool SP2 = false>
__device__ __forceinline__ void gemm_phase(PG8_LAS unsigned char* lds, const Gemm g, const Sched& S, const Epi& E) {
    int tid_o = threadIdx.x; asm volatile("" : "+v"(tid_o));
    const int tid = tid_o, wid = __builtin_amdgcn_readfirstlane(tid >> 6), lane = tid & 63, wr = wid >> 2, wc = wid & 3, fr = lane & 15, fq = lane >> 4;
    const int K = g.K, nt = K / BK;
    unsigned voffA[2], voffB[2];
#pragma unroll
    for (int i = 0; i < 2; ++i) { int R, C; stage_rc(tid * 16 + i * 8192, R, C); const int Rb = Epi::PERM ? ((R & ~31) + perm32(R & 31)) : R;
        voffA[i] = (unsigned)(R * K + C) * 2u; voffB[i] = (unsigned)(Rb * K + C) * 2u; }
    const size_t kstep = (size_t)(BK * 2);
    const size_t hstep = (size_t)HALF * K * 2;
    const size_t tstep = 2 * hstep;
    const unsigned ldsw = (unsigned)wid * 1024u;
    const int aoff = lds_byte(wr * 64 + fr, fq * 8), boff = lds_byte(wc * 32 + fr, fq * 8);
#define PG8_SA(b, h) (((b) * 2 + (h)) * HTB)
#define PG8_SB(b, h) ((4 + (b) * 2 + (h)) * HTB)
#define PG8_STAGE(bufoff, gbase, voff) do { _Pragma("unroll") for (int _i = 0; _i < 2; ++_i) \
        __builtin_amdgcn_global_load_lds((const unsigned*)((const char*)(gbase) + (voff)[_i]), (PG8_LAS unsigned*)(lds + (bufoff) + ldsw + _i * 8192), 16, 0, 0); } while (0)
#define PG8_LDA(dst, b, h) do { _Pragma("unroll") for (int m = 0; m < 4; ++m) _Pragma("unroll") for (int k = 0; k < 2; ++k) dst[m][k] = *(const PG8_LAS bf16x8*)(lds + PG8_SA(b, h) + aoff + m * 2048 + k * 1024); } while (0)
#define PG8_LDB(dst, b, h) do { _Pragma("unroll") for (int n = 0; n < 2; ++n) _Pragma("unroll") for (int k = 0; k < 2; ++k) dst[n][k] = *(const PG8_LAS bf16x8*)(lds + PG8_SB(b, h) + boff + n * 2048 + k * 1024); } while (0)
#define PG8_MMA(ai, bj, At, Bt) do { __builtin_amdgcn_s_setprio(1); _Pragma("unroll") for (int m = 0; m < 4; ++m) _Pragma("unroll") for (int n = 0; n < 2; ++n) _Pragma("unroll") for (int k = 0; k < 2; ++k) \
        acc[ai][bj][m][n] = __builtin_amdgcn_mfma_f32_16x16x32_bf16(Bt[n][k], At[m][k], acc[ai][bj][m][n], 0, 0, 0); __builtin_amdgcn_s_setprio(0); } while (0)
#define PG8_WAIT_V(n) asm volatile("s_waitcnt vmcnt(" #n ")" ::: "memory")
#define PG8_WAIT_L(n) asm volatile("s_waitcnt lgkmcnt(" #n ")" ::: "memory")
#define PG8_BAR __builtin_amdgcn_s_barrier()
#define PG8_SCHED __builtin_amdgcn_sched_barrier(0)
    Unit cur, nxt; int ui = 0;
    if (!S.next(0, cur)) return;
    f32x4 acc[2][2][4][2];
#pragma unroll
    for (int a = 0; a < 2; ++a)
#pragma unroll
        for (int b = 0; b < 2; ++b)
#pragma unroll
            for (int m = 0; m < 4; ++m)
#pragma unroll
                for (int n = 0; n < 2; ++n) acc[a][b][m][n] = (f32x4){0.f, 0.f, 0.f, 0.f};
    bf16x8 At[4][2], B0[2][2], B1[2][2];
    const char* cA = (const char*)g.A + (size_t)cur.pm * tstep; const char* cB = (const char*)g.Bt + (size_t)cur.pn * tstep;
    S.a_ready(cur);
    if constexpr (SP2) {
        PG8_STAGE(PG8_SB(0, 0), cB, voffB); PG8_STAGE(PG8_SB(0, 1), cB + hstep, voffB); PG8_STAGE(PG8_SA(0, 0), cA, voffA); PG8_STAGE(PG8_SA(0, 1), cA + hstep, voffA);
        if (wr == 1) PG8_BAR;
        PG8_WAIT_V(2); PG8_BAR;
        PG8_STAGE(PG8_SB(1, 0), cB + kstep, voffB); PG8_STAGE(PG8_SA(1, 0), cA + kstep, voffA); PG8_STAGE(PG8_SB(1, 1), cB + hstep + kstep, voffB);
        PG8_WAIT_V(6); PG8_BAR;
    } else {
        PG8_STAGE(PG8_SB(0, 0), cB, voffB); PG8_STAGE(PG8_SA(0, 0), cA, voffA); PG8_STAGE(PG8_SB(0, 1), cB + hstep, voffB); PG8_STAGE(PG8_SA(0, 1), cA + hstep, voffA);
        if (wr == 1) PG8_BAR;
        PG8_WAIT_V(4); PG8_BAR;
        PG8_STAGE(PG8_SB(1, 0), cB + kstep, voffB); PG8_STAGE(PG8_SA(1, 0), cA + kstep, voffA); PG8_STAGE(PG8_SB(1, 1), cB + hstep + kstep, voffB);
        PG8_WAIT_V(6); PG8_BAR;
    }
    for (;;) {
        const bool has_next = S.next(ui + 1, nxt);
        const char* nA = has_next ? (const char*)g.A + (size_t)nxt.pm * tstep : cA; const char* nB = has_next ? (const char*)g.Bt + (size_t)nxt.pn * tstep : cB;
#pragma nounroll
        for (int t = 0; t < nt; t += 2) {
            const bool last = (t == nt - 2);
            const char* a1 = cA + (size_t)(t + 1) * kstep;
            const char* a2 = last ? nA : cA + (size_t)(t + 2) * kstep; const char* b2 = last ? nB : cB + (size_t)(t + 2) * kstep;
            const char* a3 = a2 + kstep; const char* b3 = b2 + kstep;
            if (last && has_next) S.a_ready(nxt);
            if constexpr (SP2) {
            PG8_LDB(B0, 0, 0); PG8_LDB(B1, 0, 1); PG8_SCHED; PG8_LDA(At, 0, 0); PG8_STAGE(PG8_SA(1, 1), a1 + hstep, voffA);
            PG8_WAIT_V(8); PG8_WAIT_L(0); PG8_BAR; PG8_MMA(0, 0, At, B0); PG8_MMA(0, 1, At, B1); PG8_BAR; PG8_SCHED;
            PG8_LDA(At, 0, 1); PG8_STAGE(PG8_SB(0, 0), b2, voffB); PG8_STAGE(PG8_SB(0, 1), b2 + hstep, voffB); PG8_STAGE(PG8_SA(0, 0), a2, voffA);
            PG8_WAIT_V(8); PG8_WAIT_L(0); PG8_BAR; PG8_MMA(1, 0, At, B0); PG8_MMA(1, 1, At, B1); PG8_BAR; PG8_SCHED;
            PG8_LDB(B0, 1, 0); PG8_LDB(B1, 1, 1); PG8_SCHED; PG8_LDA(At, 1, 0); PG8_STAGE(PG8_SA(0, 1), a2 + hstep, voffA);
            PG8_WAIT_V(8); PG8_WAIT_L(0); PG8_BAR; PG8_MMA(0, 0, At, B0); PG8_MMA(0, 1, At, B1); PG8_BAR; PG8_SCHED;
            PG8_LDA(At, 1, 1); PG8_STAGE(PG8_SB(1, 0), b3, voffB); PG8_STAGE(PG8_SB(1, 1), b3 + hstep, voffB); PG8_STAGE(PG8_SA(1, 0), a3, voffA);
            PG8_WAIT_V(8); PG8_WAIT_L(0); PG8_BAR; PG8_MMA(1, 0, At, B0); PG8_MMA(1, 1, At, B1); PG8_BAR; PG8_SCHED;
            } else {
            PG8_LDB(B0, 0, 0); PG8_SCHED; PG8_LDA(At, 0, 0); PG8_STAGE(PG8_SA(1, 1), a1 + hstep, voffA);
            PG8_WAIT_L(8); PG8_BAR; PG8_WAIT_L(0); PG8_MMA(0, 0, At, B0); PG8_BAR; PG8_SCHED;
            PG8_LDB(B1, 0, 1); PG8_STAGE(PG8_SB(0, 0), b2, voffB);
            PG8_BAR; PG8_WAIT_L(0); PG8_MMA(0, 1, At, B1); PG8_BAR;
            PG8_LDA(At, 0, 1); PG8_STAGE(PG8_SA(0, 0), a2, voffA);
            PG8_BAR; PG8_WAIT_L(0); PG8_MMA(1, 0, At, B0); PG8_BAR; PG8_SCHED;
            PG8_STAGE(PG8_SB(0, 1), b2 + hstep, voffB);
            PG8_WAIT_V(6); PG8_BAR; PG8_MMA(1, 1, At, B1); PG8_BAR;
            PG8_LDB(B0, 1, 0); PG8_SCHED; PG8_LDA(At, 1, 0); PG8_STAGE(PG8_SA(0, 1), a2 + hstep, voffA);
            PG8_WAIT_L(8); PG8_BAR; PG8_WAIT_L(0); PG8_MMA(0, 0, At, B0); PG8_BAR; PG8_SCHED;
            PG8_LDB(B1, 1, 1); PG8_STAGE(PG8_SB(1, 0), b3, voffB);
            PG8_BAR; PG8_WAIT_L(0); PG8_MMA(0, 1, At, B1); PG8_BAR;
            PG8_LDA(At, 1, 1); PG8_STAGE(PG8_SA(1, 0), a3, voffA);
            PG8_BAR; PG8_WAIT_L(0); PG8_MMA(1, 0, At, B0); PG8_BAR; PG8_SCHED;
            PG8_STAGE(PG8_SB(1, 1), b3 + hstep, voffB);
            PG8_WAIT_V(6); PG8_BAR; PG8_MMA(1, 1, At, B1); PG8_BAR;
            }
        }
        if constexpr (ALIGN_EPI) { if (wr == 0) PG8_BAR; }
        if constexpr (!Epi::AFTER_DRAIN) { E(acc, cur, wr, wc, fr, fq); S.done(cur); }
        if (!has_next) break;
#pragma unroll
        for (int a = 0; a < 2; ++a)
#pragma unroll
            for (int b = 0; b < 2; ++b)
#pragma unroll
                for (int m = 0; m < 4; ++m)
#pragma unroll
                    for (int n = 0; n < 2; ++n) acc[a][b][m][n] = (f32x4){0.f, 0.f, 0.f, 0.f};
        cur = nxt; cA = nA; cB = nB; ++ui;
        if constexpr (ALIGN_EPI) { if (wr == 1) PG8_BAR; }
    }
    PG8_WAIT_V(0);
    if constexpr (!ALIGN_EPI) { if (wr == 0) PG8_BAR; }
    PG8_BAR;
    if constexpr (Epi::AFTER_DRAIN) { E.fused(acc, cur, wr, wc, fr, fq, lds, wid, lane); S.done(cur); }
#undef PG8_SA
#undef PG8_SB
#undef PG8_STAGE
#undef PG8_LDA
#undef PG8_LDB
#undef PG8_MMA
#undef PG8_WAIT_V
#undef PG8_WAIT_L
#undef PG8_BAR
#undef PG8_SCHED
}
}

#define LAS __attribute__((address_space(3)))
typedef unsigned short bf16_t;
typedef short bf16x8 __attribute__((ext_vector_type(8)));
typedef float f32x4 __attribute__((ext_vector_type(4)));
typedef float f32x2 __attribute__((ext_vector_type(2)));
typedef float f32x16 __attribute__((ext_vector_type(16)));
typedef unsigned u32x4 __attribute__((ext_vector_type(4)));
typedef unsigned u32x2 __attribute__((ext_vector_type(2)));
#define DI __device__ __forceinline__
#define GAS __attribute__((address_space(1)))

constexpr int T_TOK = 32768, DM = 1024, SEQ = 4096, NB = 8, DFF = 4096;
constexpr float EPS = 1e-6f;
constexpr float LOG2E = 1.4426950408889634f;
constexpr float QS_MLA = 0.10206207261596577f * 1.4426950408889634f;
constexpr float QS_64 = 0.125f * 1.4426950408889634f;

constexpr size_t MiB = 1u << 20;
constexpr size_t WS_COSM = 1 * MiB, WS_SINM = WS_COSM + 256 * 1024, WS_COSD = WS_SINM + 256 * 1024, WS_SIND = WS_COSD + 512 * 1024;
constexpr size_t WS_P16 = 3 * MiB;
constexpr size_t WS_PQ = 5 * MiB;
constexpr size_t WS_PKV = 6 * MiB;
constexpr size_t WS_W = 8 * MiB;
constexpr size_t WS_W1 = 474 * MiB;
constexpr size_t WS_HB = 48 * MiB;
constexpr size_t WS_R = 112 * MiB;
constexpr size_t WS_X0 = 464 * MiB;
constexpr size_t WS_LOGF = WS_X0;
constexpr size_t WS_DL = WS_X0 + 2 * MiB;
constexpr size_t WS_KPE = WS_X0 + 4 * MiB;
constexpr size_t WS_LSE = WS_X0 + 6 * MiB;
constexpr size_t WS_NEED = 510 * MiB;
constexpr size_t WO_MIX = 0, WO_QB = 786432, WO_KVB = 1376256, WO_WO = 9437184, WO_UP = 10485760, WO_DOWN = 14680064;
constexpr size_t R_CKV = 0, R_CQ = 16 * MiB, R_Q = 40 * MiB, R_KV = 136 * MiB, R_O_MLA = 264 * MiB;
constexpr size_t R_QKV = 0, R_O_FOX = 192 * MiB, R_O_DIL = 288 * MiB, R_U = 0;

constexpr int LDS_BYTES = 147456;
constexpr bool RES_LO = false;

__device__ const float INV16[16] = {1.000000000e+00f, 5.623413324e-01f, 3.162277639e-01f, 1.778279394e-01f, 1.000000015e-01f, 5.623412877e-02f, 3.162277862e-02f, 1.778279431e-02f, 9.999999776e-03f, 5.623413250e-03f, 3.162277862e-03f, 1.778279431e-03f, 1.000000047e-03f, 5.623413017e-04f, 3.162277862e-04f, 1.778279402e-04f};
__device__ const float INV32[32] = {1.000000000e+00f, 7.498942018e-01f, 5.623413324e-01f, 4.216965139e-01f, 3.162277639e-01f, 2.371373922e-01f, 1.778279394e-01f, 1.333521456e-01f, 1.000000015e-01f, 7.498941571e-02f, 5.623412877e-02f, 4.216964915e-02f, 3.162277862e-02f, 2.371373586e-02f, 1.778279431e-02f, 1.333521493e-02f, 9.999999776e-03f, 7.498942316e-03f, 5.623413250e-03f, 4.216964822e-03f, 3.162277862e-03f, 2.371373819e-03f, 1.778279431e-03f, 1.333521446e-03f, 1.000000047e-03f, 7.498941850e-04f, 5.623413017e-04f, 4.216965463e-04f, 3.162277862e-04f, 2.371373848e-04f, 1.778279402e-04f, 1.333521504e-04f};

typedef __bf16 bf16x2_t __attribute__((ext_vector_type(2)));
DI unsigned cvtpk(float lo, float hi) { const f32x2 v = {lo, hi}; const bf16x2_t b = __builtin_convertvector(v, bf16x2_t); return __builtin_bit_cast(unsigned, b); }
DI void st_bf16x4(bf16_t* p, f32x4 v) { u32x2 w; w.x = cvtpk(v.x, v.y); w.y = cvtpk(v.z, v.w); *(GAS u32x2*)p = w; }
DI f32x4 ldg4(const float* p) { return *(const GAS f32x4*)p; }
DI void stg4(float* p, f32x4 v) { *(GAS f32x4*)p = v; }
DI float dot4(f32x4 v) { return (v.x * v.x + v.y * v.y) + (v.z * v.z + v.w * v.w); }
DI float quad_sum(float s) { s += __shfl_xor(s, 16); s += __shfl_xor(s, 32); return s; }
DI float sum_part(const float* p, int n4) { float s = 0.f; for (int i = 0; i < n4; ++i) { const f32x4 v = ((const f32x4*)p)[i]; s += (v.x + v.y) + (v.z + v.w); } return s; }
DI float wave_sum(float v) {
#pragma unroll
    for (int o = 1; o < 64; o <<= 1) v += __shfl_xor(v, o);
    return v;
}

DI int otid() { int t = threadIdx.x; asm volatile("" : "+v"(t)); return t; }
DI int obid() { int b = blockIdx.x; asm volatile("" : "+s"(b)); return b; }
typedef f32x4 Acc[2][2][4][2];
#define EROW(ai, m) (u.pm * 256 + (ai) * 128 + wr * 64 + (m) * 16 + fr)
#define ECOL(bj, n) (u.pn * 256 + (bj) * 128 + wc * 32 + (n) * 16 + fq * 4)
#define EFENCE() asm volatile("" ::: "memory")

typedef unsigned long long u64;
constexpr float FX_SCALE = 1048576.f, FX_INV = 1.f / 1048576.f;
DI float ld_dev(const u64* p) { return (float)__hip_atomic_load(p, __ATOMIC_RELAXED, __HIP_MEMORY_SCOPE_AGENT) * FX_INV; }
DI void st_dev(u64* p, float v) { __hip_atomic_store(p, (u64)(v * FX_SCALE), __ATOMIC_RELAXED, __HIP_MEMORY_SCOPE_AGENT); }
DI void atomic_addf(u64* p, float v) { __hip_atomic_fetch_add(p, (u64)(v * FX_SCALE), __ATOMIC_RELAXED, __HIP_MEMORY_SCOPE_AGENT); }
DI void st_bf16x8(bf16_t* p, f32x4 a, f32x4 b) { u32x4 w; w.x = cvtpk(a.x, a.y); w.y = cvtpk(a.z, a.w); w.z = cvtpk(b.x, b.y); w.w = cvtpk(b.z, b.w); *(GAS u32x4*)p = w; }
DI float bflo(unsigned w) { return __uint_as_float(w << 16); }
DI float bfhi(unsigned w) { return __uint_as_float(w & 0xffff0000u); }
DI u32x2 split2(float a, float b) { u32x2 r; r.x = cvtpk(a, b); r.y = cvtpk(a - bflo(r.x), b - bfhi(r.x)); return r; }
#define ECOLP(bj) (u.pn * 256 + (bj) * 128 + wc * 32 + fq * 8)
struct EpiRes {
    static constexpr bool PERM = true, AFTER_DRAIN = false;
    bf16_t* hi; const bf16_t* lo_in; bf16_t* lo_out; u64* ssq;
    DI void operator()(const Acc& acc, const pg8::Unit& u, int wr, int wc, int fr, int fq) const {
#pragma unroll
        for (int ai = 0; ai < 2; ++ai)
#pragma unroll
          for (int mh = 0; mh < 2; ++mh) {
            u32x4 hh[2][2], ll[2][2];
#pragma unroll
            for (int m2 = 0; m2 < 2; ++m2)
#pragma unroll
                for (int bj = 0; bj < 2; ++bj) { const size_t off = (size_t)EROW(ai, 2 * mh + m2) * DM + ECOLP(bj); hh[m2][bj] = *(const GAS u32x4*)(hi + off); ll[m2][bj] = RES_LO ? *(const GAS u32x4*)(lo_in + off) : (u32x4){0u, 0u, 0u, 0u}; }
#pragma unroll
            for (int m2 = 0; m2 < 2; ++m2) {
                const int m = 2 * mh + m2;
                const size_t row = EROW(ai, m); float ss = 0.f;
#pragma unroll
                for (int bj = 0; bj < 2; ++bj) {
                    const size_t off = row * DM + ECOLP(bj);
                    const u32x4 H = hh[m2][bj], L = ll[m2][bj]; const f32x4 a0 = acc[ai][bj][m][0], a1 = acc[ai][bj][m][1];
                    float v[8];
                    v[0] = bflo(H.x) + bflo(L.x) + a0.x; v[1] = bfhi(H.x) + bfhi(L.x) + a0.y; v[2] = bflo(H.y) + bflo(L.y) + a0.z; v[3] = bfhi(H.y) + bfhi(L.y) + a0.w;
                    v[4] = bflo(H.z) + bflo(L.z) + a1.x; v[5] = bfhi(H.z) + bfhi(L.z) + a1.y; v[6] = bflo(H.w) + bflo(L.w) + a1.z; v[7] = bfhi(H.w) + bfhi(L.w) + a1.w;
                    u32x4 nh, nl;
                    { const u32x2 s0 = split2(v[0], v[1]), s1 = split2(v[2], v[3]), s2 = split2(v[4], v[5]), s3 = split2(v[6], v[7]); nh.x = s0.x; nl.x = s0.y; nh.y = s1.x; nl.y = s1.y; nh.z = s2.x; nl.z = s2.y; nh.w = s3.x; nl.w = s3.y; }
                    *(GAS u32x4*)(hi + off) = nh; if (RES_LO) *(GAS u32x4*)(lo_out + off) = nl;
#pragma unroll
                    for (int k = 0; k < 8; ++k) ss += v[k] * v[k];
                }
                ss = quad_sum(ss);
                if (fq == 0) atomic_addf(ssq + row, ss);
            }
            EFENCE();
        }
    }
};
struct EpiUp {
    static constexpr bool PERM = true, AFTER_DRAIN = false;
    const u64* ssq; bf16_t* out;
    DI void operator()(const Acc& acc, const pg8::Unit& u, int wr, int wc, int fr, int fq) const {
        float rs[2][4];
#pragma unroll
        for (int ai = 0; ai < 2; ++ai)
#pragma unroll
            for (int m = 0; m < 4; ++m) rs[ai][m] = ld_dev(ssq + EROW(ai, m));
#pragma unroll
        for (int ai = 0; ai < 2; ++ai)
#pragma unroll
            for (int m = 0; m < 4; ++m) {
                const size_t row = EROW(ai, m);
                const float r = rsqrtf(rs[ai][m] * (1.f / 1024.f) + EPS);
#pragma unroll
                for (int bj = 0; bj < 2; ++bj) {
                    f32x4 v0 = acc[ai][bj][m][0] * r, v1 = acc[ai][bj][m][1] * r;
                    v0.x = fmaxf(v0.x, 0.f); v0.y = fmaxf(v0.y, 0.f); v0.z = fmaxf(v0.z, 0.f); v0.w = fmaxf(v0.w, 0.f);
                    v1.x = fmaxf(v1.x, 0.f); v1.y = fmaxf(v1.y, 0.f); v1.z = fmaxf(v1.z, 0.f); v1.w = fmaxf(v1.w, 0.f);
                    st_bf16x8(out + row * DFF + ECOLP(bj), v0 * v0, v1 * v1);
                }
            }
    }
};
struct EpiMlaA {
    static constexpr bool PERM = true, AFTER_DRAIN = false;
    const u64* ssq; bf16_t* ckv; bf16_t* cq; bf16_t* kpe; u64* sq; u64* skv; const float* cosM; const float* sinM;
    DI void operator()(const Acc& acc, const pg8::Unit& u, int wr, int wc, int fr, int fq) const {
        float rsv[2][4];
#pragma unroll
        for (int ai = 0; ai < 2; ++ai)
#pragma unroll
            for (int m = 0; m < 4; ++m) rsv[ai][m] = ld_dev(ssq + EROW(ai, m));
#pragma unroll
        for (int ai = 0; ai < 2; ++ai)
#pragma unroll
            for (int m = 0; m < 4; ++m) {
                const size_t row = EROW(ai, m);
                const float rs = rsqrtf(rsv[ai][m] * (1.f / 1024.f) + EPS);
                float ss = 0.f;
                if (u.pn == 0) {
#pragma unroll
                    for (int bj = 0; bj < 2; ++bj) { const f32x4 v0 = acc[ai][bj][m][0] * rs, v1 = acc[ai][bj][m][1] * rs; ss += dot4(v0) + dot4(v1); st_bf16x8(ckv + row * 256 + bj * 128 + wc * 32 + fq * 8, v0, v1); }
                    ss = quad_sum(ss); if (fq == 0) atomic_addf(skv + row, ss);
                } else if (u.pn == 1) {
#pragma unroll
                    for (int bj = 0; bj < 2; ++bj) { const f32x4 v0 = acc[ai][bj][m][0] * rs, v1 = acc[ai][bj][m][1] * rs; ss += dot4(v0) + dot4(v1); st_bf16x8(cq + row * 384 + bj * 128 + wc * 32 + fq * 8, v0, v1); }
                    ss = quad_sum(ss); if (fq == 0) atomic_addf(sq + row, ss);
                } else {
                    { const f32x4 v0 = acc[ai][0][m][0] * rs, v1 = acc[ai][0][m][1] * rs; ss += dot4(v0) + dot4(v1); st_bf16x8(cq + row * 384 + 256 + wc * 32 + fq * 8, v0, v1); }
                    ss = quad_sum(ss); if (fq == 0) atomic_addf(sq + row, ss);
                    if (wc == 0) {
                        const int pos = (int)(row & (SEQ - 1));
                        const f32x4 c = ldg4(cosM + pos * 16 + fq * 4), s = ldg4(sinM + pos * 16 + fq * 4);
                        const f32x4 x1 = acc[ai][1][m][0] * rs, x2 = acc[ai][1][m][1] * rs;
                        st_bf16x8(kpe + row * 32 + fq * 8, x1 * c - x2 * s, x1 * s + x2 * c);
                    }
                }
            }
    }
};
struct EpiMlaQ {
    static constexpr bool PERM = true, AFTER_DRAIN = false;
    const u64* sq; bf16_t* Q; const float* cosM; const float* sinM;
    DI void operator()(const Acc& acc, const pg8::Unit& u, int wr, int wc, int fr, int fq) const {
        float rsv[2][4];
#pragma unroll
        for (int ai = 0; ai < 2; ++ai)
#pragma unroll
            for (int m = 0; m < 4; ++m) rsv[ai][m] = ld_dev(sq + EROW(ai, m));
#pragma unroll
        for (int ai = 0; ai < 2; ++ai)
#pragma unroll
            for (int m = 0; m < 4; ++m) {
                const size_t row = EROW(ai, m);
                const float rs = rsqrtf(rsv[ai][m] * (1.f / 384.f) + EPS) * QS_MLA;
                const int toff = (int)(row & (SEQ - 1)) * 16 + fq * 4;
#pragma unroll
                for (int bj = 0; bj < 2; ++bj) {
                    const int g32 = 8 * u.pn + 4 * bj + wc;
                    bf16_t* dst = Q + row * 1536 + ECOLP(bj);
                    const f32x4 x1 = acc[ai][bj][m][0] * rs, x2 = acc[ai][bj][m][1] * rs;
                    if (g32 % 3 == 2) {
                        const f32x4 c = ldg4(cosM + toff), s = ldg4(sinM + toff);
                        st_bf16x8(dst, x1 * c - x2 * s, x1 * s + x2 * c);
                    } else st_bf16x8(dst, x1, x2);
                }
            }
    }
};
struct EpiMlaKV {
    static constexpr bool PERM = true, AFTER_DRAIN = false;
    const u64* skv; bf16_t* KV;
    DI void operator()(const Acc& acc, const pg8::Unit& u, int wr, int wc, int fr, int fq) const {
        float rsv[2][4];
#pragma unroll
        for (int ai = 0; ai < 2; ++ai)
#pragma unroll
            for (int m = 0; m < 4; ++m) rsv[ai][m] = ld_dev(skv + EROW(ai, m));
#pragma unroll
        for (int ai = 0; ai < 2; ++ai)
#pragma unroll
            for (int m = 0; m < 4; ++m) {
                const size_t row = EROW(ai, m);
                const float rs = rsqrtf(rsv[ai][m] * (1.f / 256.f) + EPS);
#pragma unroll
                for (int bj = 0; bj < 2; ++bj) st_bf16x8(KV + row * 2048 + ECOLP(bj), acc[ai][bj][m][0] * rs, acc[ai][bj][m][1] * rs);
            }
    }
};
struct EpiFox {
    static constexpr bool PERM = true, AFTER_DRAIN = false;
    const u64* ssq; bf16_t* qkv; float* logf; const float* bf;
    DI void operator()(const Acc& acc, const pg8::Unit& u, int wr, int wc, int fr, int fq) const {
        float rsv[2][4];
#pragma unroll
        for (int ai = 0; ai < 2; ++ai)
#pragma unroll
            for (int m = 0; m < 4; ++m) rsv[ai][m] = ld_dev(ssq + EROW(ai, m));
#pragma unroll
        for (int ai = 0; ai < 2; ++ai)
#pragma unroll
            for (int m = 0; m < 4; ++m) {
                const size_t row = EROW(ai, m);
                const float rs = rsqrtf(rsv[ai][m] * (1.f / 1024.f) + EPS);
                if (u.pn < 12) {
                    const float sc = (u.pn < 4) ? rs * QS_64 : rs;
#pragma unroll
                    for (int bj = 0; bj < 2; ++bj) st_bf16x8(qkv + row * 3072 + ECOLP(bj), acc[ai][bj][m][0] * sc, acc[ai][bj][m][1] * sc);
                } else if (wc == 0 && fq < 2) {
#pragma unroll
                    for (int n = 0; n < 2; ++n) {
                        const f32x4 b = ldg4(bf + fq * 8 + 4 * n); const f32x4 x = acc[ai][0][m][n] * rs + b; f32x4 o;
#pragma unroll
                        for (int e = 0; e < 4; ++e) { const float xv = x[e]; o[e] = fminf(xv, 0.f) - __logf(1.f + __expf(-fabsf(xv))); }
                        stg4(logf + row * 16 + fq * 8 + 4 * n, o);
                    }
                }
            }
    }
};
struct EpiDil {
    static constexpr bool PERM = true, AFTER_DRAIN = false;
    const u64* ssq; bf16_t* qkv; const float* cosD; const float* sinD;
    DI void operator()(const Acc& acc, const pg8::Unit& u, int wr, int wc, int fr, int fq) const {
        const int sel = u.pn / 12;
        const int gg = (u.pn % 12) >> 2, ld = 2 * gg;
        float rsv[2][4];
#pragma unroll
        for (int ai = 0; ai < 2; ++ai)
#pragma unroll
            for (int m = 0; m < 4; ++m) rsv[ai][m] = ld_dev(ssq + EROW(ai, m));
#pragma unroll
        for (int ai = 0; ai < 2; ++ai)
#pragma unroll
            for (int m = 0; m < 4; ++m) {
                const size_t row = EROW(ai, m);
                const float rs0 = rsqrtf(rsv[ai][m] * (1.f / 1024.f) + EPS);
                const float rs = (sel == 0) ? rs0 * QS_64 : rs0;
                const int pos = (int)(row & (SEQ - 1));
                const int rho = ((pos & ((1 << ld) - 1)) << (12 - ld)) + (pos >> ld);
                f32x4 c = {0.f, 0.f, 0.f, 0.f}, s = c;
                if (sel < 2) { const int i0 = 16 * (wc & 1) + fq * 4; c = ldg4(cosD + pos * 32 + i0); s = ldg4(sinD + pos * 32 + i0); }
#pragma unroll
                for (int bj = 0; bj < 2; ++bj) {
                    f32x4 x1 = acc[ai][bj][m][0] * rs, x2 = acc[ai][bj][m][1] * rs;
                    if (sel < 2) { const f32x4 o1 = x1 * c - x2 * s, o2 = x1 * s + x2 * c; x1 = o1; x2 = o2; }
                    const int hd = ((u.pn & 3) << 2) + 2 * bj + (wc >> 1);
                    bf16_t* dst = qkv + ((size_t)((((int)(row >> 12) * 3 + sel) * 3 + gg) * 16 + hd) * 4096 + rho) * 64 + 32 * (wc & 1) + 8 * fq;
                    st_bf16x8(dst, x1, x2);
                }
            }
    }
};

DI void store_o_row(bf16_t* orow, const f32x16& o0, const f32x16& o1, float inv, int h) {
#pragma unroll
    for (int blk = 0; blk < 2; ++blk)
#pragma unroll
        for (int gp = 0; gp < 2; ++gp) {
            const f32x16& o = blk ? o1 : o0;
            const int ge = 8 * gp, go = 8 * gp + 4;
            const unsigned e0 = cvtpk(o[ge] * inv, o[ge + 1] * inv), e1 = cvtpk(o[ge + 2] * inv, o[ge + 3] * inv);
            const unsigned q0 = cvtpk(o[go] * inv, o[go + 1] * inv), q1 = cvtpk(o[go + 2] * inv, o[go + 3] * inv);
            const auto s0 = __builtin_amdgcn_permlane32_swap(e0, q0, false, false);
            const auto s1 = __builtin_amdgcn_permlane32_swap(e1, q1, false, false);
            u32x4 w; w.x = s0[0]; w.y = s1[0]; w.z = s0[1]; w.w = s1[1];
            *(GAS u32x4*)(orow + 32 * blk + 16 * gp + 8 * h) = w;
        }
}
typedef short v4i16_t __attribute__((ext_vector_type(4)));
DI bf16x8 vtr8(const LAS unsigned char* p, int row_pitch4) {
    const v4i16_t lo = __builtin_amdgcn_ds_read_tr16_b64_v4i16((LAS v4i16_t*)p), hi = __builtin_amdgcn_ds_read_tr16_b64_v4i16((LAS v4i16_t*)(p + row_pitch4));
    return (bf16x8){lo[0], lo[1], lo[2], lo[3], hi[0], hi[1], hi[2], hi[3]};
}
#define AT_VTR(p) vtr8((p), 4 * VP)
template <int DK, int MODE>
DI void attn_unit(LAS unsigned char* lds, const bf16_t* Qp, long qpitch, const bf16_t* Kp, long kpitch, const bf16_t* K2p, long k2pitch,
                  const bf16_t* Vp, long vpitch, bf16_t* Op, long opitch, const float* Dl, float* lsep, long lsepitch, int q0, int W,
                  bool pre, bool has_next, const bf16_t* Kn, const bf16_t* K2n, const bf16_t* Vn, const float* Dln,
                  u32x4& kreg0, u32x4& kreg1, u32x4& k2reg, u32x4& vreg0, u32x4& vreg1, f32x4& dkreg) {
    constexpr int KP = DK * 2 + 16, NS = DK / 16, VP = 192, VT_OFF = 128 * 208, DK_OFF = VT_OFF + 128 * VP, BUFSZ = 52224;
    static_assert(DK_OFF + 512 <= BUFSZ, "lds");
    constexpr float THR = 8.f;
    const int tid = otid(), lane = tid & 63, r = lane & 31, h = lane >> 5;
    const int wid = __builtin_amdgcn_readfirstlane(tid >> 6);
    const int wq0 = q0 + 32 * wid, q = wq0 + r;
    bf16x8 qf[NS];
    { const bf16_t* qrow = Qp + (long)q * qpitch;
#pragma unroll
      for (int s = 0; s < NS; ++s) qf[s] = *(const GAS bf16x8*)(qrow + 16 * s + 8 * h); }
    float dq = 0.f; if (MODE == 1) dq = *(const GAS float*)(Dl + q);
    f32x16 o0, o1;
#pragma unroll
    for (int i = 0; i < 16; ++i) { o0[i] = 0.f; o1[i] = 0.f; }
    float m_ref = 0.f, l_run = 0.f; bool first = true;
    const int t_lo = 0; (void)W;
    const int t_hi = (q0 + 255) >> 7;
    const int lkey = tid >> 3, lch = tid & 7;
#define AT_ISSUE(t) do { const long kb_ = 128L * (t); \
        kreg0 = *(const GAS u32x4*)(Kp + (kb_ + lkey) * kpitch + lch * 8); kreg1 = *(const GAS u32x4*)(Kp + (kb_ + lkey + 64) * kpitch + lch * 8); \
        if (MODE == 0) k2reg = *(const GAS u32x4*)(K2p + (kb_ + (tid >> 2)) * k2pitch + (tid & 3) * 8); \
        vreg0 = *(const GAS u32x4*)(Vp + (kb_ + lkey) * vpitch + lch * 8); vreg1 = *(const GAS u32x4*)(Vp + (kb_ + lkey + 64) * vpitch + lch * 8); \
        if (MODE == 1 && tid < 32) dkreg = *(const GAS f32x4*)(Dl + kb_ + 4 * tid); } while (0)
#define AT_WRITE(bufp) do { LAS unsigned char* b_ = (bufp); \
        *(LAS u32x4*)(b_ + lkey * KP + lch * 16) = kreg0; *(LAS u32x4*)(b_ + (lkey + 64) * KP + lch * 16) = kreg1; \
        if (MODE == 0) *(LAS u32x4*)(b_ + (tid >> 2) * KP + 128 + (tid & 3) * 16) = k2reg; \
        *(LAS u32x4*)(b_ + VT_OFF + lkey * VP + lch * 16) = vreg0; *(LAS u32x4*)(b_ + VT_OFF + (lkey + 64) * VP + lch * 16) = vreg1; \
        if (MODE == 1 && tid < 32) *(LAS f32x4*)(b_ + DK_OFF + 16 * tid) = dkreg; } while (0)
#define AT_ISSUE_NEXT() do { \
        kreg0 = *(const GAS u32x4*)(Kn + (long)lkey * kpitch + lch * 8); kreg1 = *(const GAS u32x4*)(Kn + (long)(lkey + 64) * kpitch + lch * 8); \
        if (MODE == 0) k2reg = *(const GAS u32x4*)(K2n + (long)(tid >> 2) * k2pitch + (tid & 3) * 8); \
        vreg0 = *(const GAS u32x4*)(Vn + (long)lkey * vpitch + lch * 8); vreg1 = *(const GAS u32x4*)(Vn + (long)(lkey + 64) * vpitch + lch * 8); \
        if (MODE == 1 && tid < 32) dkreg = *(const GAS f32x4*)(Dln + 4 * tid); } while (0)
    if (!pre) AT_ISSUE(t_lo);
    AT_WRITE(lds + (t_lo & 1) * BUFSZ);
    if (t_lo < t_hi) AT_ISSUE(t_lo + 1);
    __syncthreads();
    const int pr = (r & 19) | ((r & 4) << 1) | ((r & 8) >> 1);
    const int vtr_base = (8 * h + ((lane & 15) >> 2)) * VP + (16 * ((lane >> 4) & 1) + 4 * (lane & 3)) * 2;
#define AT_S(P0, P1, SUB) do { \
        const LAS unsigned char* ka_ = buf + (64 * (SUB) + pr) * KP + h * 16; constexpr int NH = NS / 2; bf16x8 kf[2 * NH]; \
        _Pragma("unroll") for (int s = 0; s < NH; ++s) { kf[2 * s] = *(const LAS bf16x8*)(ka_ + s * 32); kf[2 * s + 1] = *(const LAS bf16x8*)(ka_ + 32 * KP + s * 32); } \
        f32x16 i0_, i1_; \
        if (MODE == 1) { const float base = dq - m_ref; const LAS unsigned char* dk_ = buf + DK_OFF + 256 * (SUB); \
            _Pragma("unroll") for (int a = 0; a < 2; ++a) { \
                const f32x4 d0 = *(const LAS f32x4*)(dk_ + 4 * (16 * a + 8 * h)), d1 = *(const LAS f32x4*)(dk_ + 4 * (16 * a + 8 * h + 4)); \
                const f32x4 e0 = *(const LAS f32x4*)(dk_ + 4 * (32 + 16 * a + 8 * h)), e1 = *(const LAS f32x4*)(dk_ + 4 * (32 + 16 * a + 8 * h + 4)); \
                _Pragma("unroll") for (int e = 0; e < 4; ++e) { i0_[8 * a + e] = base - d0[e]; i0_[8 * a + 4 + e] = base - d1[e]; i1_[8 * a + e] = base - e0[e]; i1_[8 * a + 4 + e] = base - e1[e]; } } } \
        else { _Pragma("unroll") for (int i = 0; i < 16; ++i) { i0_[i] = -m_ref; i1_[i] = -m_ref; } } \
        \
        P0 = __builtin_amdgcn_mfma_f32_32x32x16_bf16(kf[0], qf[0], i0_, 0, 0, 0); P1 = __builtin_amdgcn_mfma_f32_32x32x16_bf16(kf[1], qf[0], i1_, 0, 0, 0); \
        _Pragma("unroll") for (int s = 1; s < NH; ++s) { \
            P0 = __builtin_amdgcn_mfma_f32_32x32x16_bf16(kf[2 * s], qf[s], P0, 0, 0, 0); P1 = __builtin_amdgcn_mfma_f32_32x32x16_bf16(kf[2 * s + 1], qf[s], P1, 0, 0, 0); } \
        _Pragma("unroll") for (int s = 0; s < NH; ++s) { kf[2 * s] = *(const LAS bf16x8*)(ka_ + (NH + s) * 32); kf[2 * s + 1] = *(const LAS bf16x8*)(ka_ + 32 * KP + (NH + s) * 32); } \
        \
        _Pragma("unroll") for (int s = 0; s < NH; ++s) { \
            P0 = __builtin_amdgcn_mfma_f32_32x32x16_bf16(kf[2 * s], qf[NH + s], P0, 0, 0, 0); P1 = __builtin_amdgcn_mfma_f32_32x32x16_bf16(kf[2 * s + 1], qf[NH + s], P1, 0, 0, 0); } \
        } while (0)
#define AT_SM(P0, P1, SUB, ADJ, OTH0, OTH1) do { \
        const int kb_ = 128 * t + 64 * (SUB); \
        const LAS unsigned char* va_ = buf + VT_OFF + vtr_base + 64 * (SUB) * VP; bf16x8 vf[4]; \
        _Pragma("unroll") for (int s = 0; s < 2; ++s) { vf[2 * s] = AT_VTR(va_ + 16 * s * VP); vf[2 * s + 1] = AT_VTR(va_ + 16 * s * VP + 64); } \
        if (kb_ + 63 > wq0) {     \
            _Pragma("unroll") for (int i = 0; i < 16; ++i) { const int kk = kb_ + (i & 7) + 8 * h + 16 * (i >> 3); \
                if (kk > q) P0[i] = -1e30f; if (kk + 32 > q) P1[i] = -1e30f; } } \
        float mxa = fmaxf(fmaxf(P0[0], P1[0]), P0[1]), mxb = fmaxf(fmaxf(P0[4], P1[4]), P0[5]), mxc = fmaxf(fmaxf(P0[8], P1[8]), P0[9]), mxd = fmaxf(fmaxf(P0[12], P1[12]), P0[13]); \
        mxa = fmaxf(fmaxf(mxa, P1[1]), P0[2]); mxb = fmaxf(fmaxf(mxb, P1[5]), P0[6]); mxc = fmaxf(fmaxf(mxc, P1[9]), P0[10]); mxd = fmaxf(fmaxf(mxd, P1[13]), P0[14]); \
        mxa = fmaxf(fmaxf(mxa, P1[2]), P0[3]); mxb = fmaxf(fmaxf(mxb, P1[6]), P0[7]); mxc = fmaxf(fmaxf(mxc, P1[10]), P0[11]); mxd = fmaxf(fmaxf(mxd, P1[14]), P0[15]); \
        mxa = fmaxf(fmaxf(mxa, P1[3]), mxb); mxc = fmaxf(fmaxf(mxc, P1[7]), mxd); float mx = fmaxf(fmaxf(mxa, P1[11]), fmaxf(mxc, P1[15])); \
        { const auto rr_ = __builtin_amdgcn_permlane32_swap(__float_as_uint(mx), __float_as_uint(mx), false, false); mx = fmaxf(__uint_as_float(rr_[0]), __uint_as_float(rr_[1])); } \
        if (first || __any(mx > THR)) { \
            const float dl = first ? mx : fmaxf(mx, 0.f); m_ref += dl; \
            if (!first) { const float alpha = __builtin_amdgcn_exp2f(-dl); l_run *= alpha; o0 *= alpha; o1 *= alpha; } \
            _Pragma("unroll") for (int i = 0; i < 16; ++i) { P0[i] -= dl; P1[i] -= dl; } \
            if (ADJ) { _Pragma("unroll") for (int i = 0; i < 16; ++i) { OTH0[i] -= dl; OTH1[i] -= dl; } } \
            first = false; } \
        float ls0 = 0.f, ls1 = 0.f, ls2 = 0.f, ls3 = 0.f; \
        _Pragma("unroll") for (int i = 0; i < 16; i += 4) { \
            P0[i] = __builtin_amdgcn_exp2f(P0[i]); P1[i] = __builtin_amdgcn_exp2f(P1[i]); P0[i + 1] = __builtin_amdgcn_exp2f(P0[i + 1]); P1[i + 1] = __builtin_amdgcn_exp2f(P1[i + 1]); \
            P0[i + 2] = __builtin_amdgcn_exp2f(P0[i + 2]); P1[i + 2] = __builtin_amdgcn_exp2f(P1[i + 2]); P0[i + 3] = __builtin_amdgcn_exp2f(P0[i + 3]); P1[i + 3] = __builtin_amdgcn_exp2f(P1[i + 3]); \
            ls0 += P0[i] + P1[i]; ls1 += P0[i + 1] + P1[i + 1]; ls2 += P0[i + 2] + P1[i + 2]; ls3 += P0[i + 3] + P1[i + 3]; } \
        l_run += (ls0 + ls1) + (ls2 + ls3); \
        u32x4 w0, w1, w2, w3; \
        w0.x = cvtpk(P0[0], P0[1]); w0.y = cvtpk(P0[2], P0[3]); w0.z = cvtpk(P0[4], P0[5]); w0.w = cvtpk(P0[6], P0[7]); \
        w1.x = cvtpk(P0[8], P0[9]); w1.y = cvtpk(P0[10], P0[11]); w1.z = cvtpk(P0[12], P0[13]); w1.w = cvtpk(P0[14], P0[15]); \
        w2.x = cvtpk(P1[0], P1[1]); w2.y = cvtpk(P1[2], P1[3]); w2.z = cvtpk(P1[4], P1[5]); w2.w = cvtpk(P1[6], P1[7]); \
        w3.x = cvtpk(P1[8], P1[9]); w3.y = cvtpk(P1[10], P1[11]); w3.z = cvtpk(P1[12], P1[13]); w3.w = cvtpk(P1[14], P1[15]); \
        const bf16x8 pf0 = __builtin_bit_cast(bf16x8, w0), pf1 = __builtin_bit_cast(bf16x8, w1), pf2 = __builtin_bit_cast(bf16x8, w2), pf3 = __builtin_bit_cast(bf16x8, w3); \
        \
        o0 = __builtin_amdgcn_mfma_f32_32x32x16_bf16(vf[0], pf0, o0, 0, 0, 0); o1 = __builtin_amdgcn_mfma_f32_32x32x16_bf16(vf[1], pf0, o1, 0, 0, 0); \
        o0 = __builtin_amdgcn_mfma_f32_32x32x16_bf16(vf[2], pf1, o0, 0, 0, 0); o1 = __builtin_amdgcn_mfma_f32_32x32x16_bf16(vf[3], pf1, o1, 0, 0, 0); \
        _Pragma("unroll") for (int s = 0; s < 2; ++s) { vf[2 * s] = AT_VTR(va_ + 16 * (s + 2) * VP); vf[2 * s + 1] = AT_VTR(va_ + 16 * (s + 2) * VP + 64); } \
        \
        o0 = __builtin_amdgcn_mfma_f32_32x32x16_bf16(vf[0], pf2, o0, 0, 0, 0); o1 = __builtin_amdgcn_mfma_f32_32x32x16_bf16(vf[1], pf2, o1, 0, 0, 0); \
        o0 = __builtin_amdgcn_mfma_f32_32x32x16_bf16(vf[2], pf3, o0, 0, 0, 0); o1 = __builtin_amdgcn_mfma_f32_32x32x16_bf16(vf[3], pf3, o1, 0, 0, 0); \
        } while (0)
    for (int t = t_lo; t <= t_hi; ++t) {
        if (t < t_hi) { AT_WRITE(lds + ((t + 1) & 1) * BUFSZ); if (t + 1 < t_hi) AT_ISSUE(t + 2); }
        if (t == t_hi && has_next) AT_ISSUE_NEXT();
        const LAS unsigned char* buf = lds + (t & 1) * BUFSZ;
        const int kbA = 128 * t, kbB = kbA + 64;
        const bool actA = (kbA <= wq0 + 31);
        const bool actB = (kbB <= wq0 + 31);
        f32x16 pA0, pA1, pB0, pB1;
        if (actA && actB) {
            AT_S(pA0, pA1, 0); AT_S(pB0, pB1, 1);
            AT_SM(pA0, pA1, 0, true, pB0, pB1);
            AT_SM(pB0, pB1, 1, false, pA0, pA1);
        } else if (actA) {
            AT_S(pA0, pA1, 0); AT_SM(pA0, pA1, 0, false, pB0, pB1);
        } else if (actB) {
            AT_S(pB0, pB1, 1); AT_SM(pB0, pB1, 1, false, pA0, pA1);
        }
        __syncthreads();
    }
#undef AT_ISSUE
#undef AT_ISSUE_NEXT
#undef AT_WRITE
#undef AT_S
#undef AT_SM
    const float l_tot = l_run + __shfl_xor(l_run, 32);
    const float inv = 1.f / l_tot;
    bf16_t* orow = Op + (long)q * opitch;
    store_o_row(orow, o0, o1, inv, h);
    if (MODE == 2 && h == 0) *(GAS float*)(lsep + (long)q * lsepitch) = m_ref + __log2f(l_tot);
}

DI void dil_decode(int L, const bf16_t* QKVC, size_t& qoff, size_t& koff, size_t& voff, size_t& lseoff, int& lsepitch, int& q0) {
    const int j = L & 15, g3 = (L >> 4) % 3, rest = (L >> 4) / 3, hd = rest & 15, bl = rest >> 4;
    const int d = (g3 == 0) ? 1 : (g3 == 1) ? 4 : 16;
    const int res = (g3 == 0) ? 0 : (g3 == 1) ? (j >> 2) : j;
    const int qb = (g3 == 0) ? j : (g3 == 1) ? (j & 3) : 0;
    const size_t prow = (size_t)res * (SEQ / d);
    qoff = ((size_t)(((bl * 3 + 0) * 3 + g3) * 16 + hd) * 4096 + prow) * 64;
    koff = ((size_t)(((bl * 3 + 1) * 3 + g3) * 16 + hd) * 4096 + prow) * 64;
    voff = ((size_t)(((bl * 3 + 2) * 3 + g3) * 16 + hd) * 4096 + prow) * 64;
    lseoff = ((size_t)bl * SEQ + res) * 48 + g3 * 16 + hd; lsepitch = d * 48; q0 = qb * 256;
}
DI void dil_phase(LAS unsigned char* lds, bf16_t* QKVC, float* LSE, int bx, int G) {
    constexpr int KP = 144, VP = 192, VT_OFF = 384 * KP, W = 128;
    constexpr float THR = 8.f;
    const int tid = otid(), lane = tid & 63, r = lane & 31, h = lane >> 5;
    const int wid = __builtin_amdgcn_readfirstlane(tid >> 6);
    const int lkey = tid >> 3, lch = tid & 7;
    const int pr = (r & 19) | ((r & 4) << 1) | ((r & 8) >> 1);
    const int vtr_base = (8 * h + ((lane & 15) >> 2)) * VP + (16 * ((lane >> 4) & 1) + 4 * (lane & 3)) * 2;
    u32x4 kreg[6], vreg[6]; bf16x8 qn[4];
    int L = bx; if (L >= 3072) return;
    size_t qoff, koff, voff, lseoff; int lsepitch, q0;
    dil_decode(L, QKVC, qoff, koff, voff, lseoff, lsepitch, q0);
#define DL_ISSUE(QO, KO, VO, Q0) do { const int kbase_ = ((Q0) == 0) ? 0 : (Q0) - 128; \
        _Pragma("unroll") for (int j = 0; j < 6; ++j) if (j < 4 || (Q0) != 0) { \
            kreg[j] = *(const GAS u32x4*)(QKVC + (KO) + (size_t)(kbase_ + lkey + 64 * j) * 64 + lch * 8); \
            vreg[j] = *(const GAS u32x4*)(QKVC + (VO) + (size_t)(kbase_ + lkey + 64 * j) * 64 + lch * 8); } \
        _Pragma("unroll") for (int s = 0; s < 4; ++s) qn[s] = *(const GAS bf16x8*)(QKVC + (QO) + (size_t)((Q0) + 32 * wid + r) * 64 + 16 * s + 8 * h); } while (0)
    DL_ISSUE(qoff, koff, voff, q0);
    for (;;) {
        const int nj = (q0 == 0) ? 4 : 6, kbase = (q0 == 0) ? 0 : q0 - 128;
#pragma unroll
        for (int j = 0; j < 6; ++j) if (j < nj) {
            *(LAS u32x4*)(lds + (lkey + 64 * j) * KP + lch * 16) = kreg[j];
            *(LAS u32x4*)(lds + VT_OFF + (lkey + 64 * j) * VP + lch * 16) = vreg[j];
        }
        bf16x8 qf[4];
#pragma unroll
        for (int s = 0; s < 4; ++s) qf[s] = qn[s];
        __syncthreads();
        const int Ln = L + G; const bool has_next = Ln < 3072;
        size_t nqoff = 0, nkoff = 0, nvoff = 0, nlseoff = 0; int nlsepitch = 0, nq0 = 0;
        if (has_next) { dil_decode(Ln, QKVC, nqoff, nkoff, nvoff, nlseoff, nlsepitch, nq0); DL_ISSUE(nqoff, nkoff, nvoff, nq0); }
        const int wq0 = q0 + 32 * wid, q = wq0 + r;
        f32x16 o0, o1;
#pragma unroll
        for (int i = 0; i < 16; ++i) { o0[i] = 0.f; o1[i] = 0.f; }
        float m_ref = 0.f, l_run = 0.f; bool first = true;
        int u_lo = (wq0 - W - kbase) >> 6; if (u_lo < 0) u_lo = 0;
        int u_hi = (wq0 + 31 - kbase) >> 6; if (u_hi > nj - 1) u_hi = nj - 1;
        for (int u = u_lo; u <= u_hi; ++u) {
            const int kb = kbase + 64 * u;
            const LAS unsigned char* ka = lds + (64 * u + pr) * KP + h * 16;
            bf16x8 kf[8];
#pragma unroll
            for (int s = 0; s < 4; ++s) { kf[2 * s] = *(const LAS bf16x8*)(ka + s * 32); kf[2 * s + 1] = *(const LAS bf16x8*)(ka + 32 * KP + s * 32); }
            f32x16 p0, p1;
#pragma unroll
            for (int i = 0; i < 16; ++i) { p0[i] = -m_ref; p1[i] = -m_ref; }
#pragma unroll
            for (int s = 0; s < 4; ++s) {
                p0 = __builtin_amdgcn_mfma_f32_32x32x16_bf16(kf[2 * s], qf[s], p0, 0, 0, 0);
                p1 = __builtin_amdgcn_mfma_f32_32x32x16_bf16(kf[2 * s + 1], qf[s], p1, 0, 0, 0);
            }
            const LAS unsigned char* va = lds + VT_OFF + vtr_base + 64 * u * VP; bf16x8 vf[8];
#pragma unroll
            for (int s = 0; s < 4; ++s) { vf[2 * s] = vtr8(va + 16 * s * VP, 4 * VP); vf[2 * s + 1] = vtr8(va + 16 * s * VP + 64, 4 * VP); }
            if ((kb + 63 > wq0) || (kb < wq0 + 31 - W)) {
#pragma unroll
                for (int i = 0; i < 16; ++i) { const int kk = kb + (i & 7) + 8 * h + 16 * (i >> 3);
                    if (kk > q || kk < q - W) p0[i] = -1e30f; if (kk + 32 > q || kk + 32 < q - W) p1[i] = -1e30f; }
            }
            float mxa = fmaxf(fmaxf(p0[0], p1[0]), p0[1]), mxb = fmaxf(fmaxf(p0[4], p1[4]), p0[5]), mxc = fmaxf(fmaxf(p0[8], p1[8]), p0[9]), mxd = fmaxf(fmaxf(p0[12], p1[12]), p0[13]);
            mxa = fmaxf(fmaxf(mxa, p1[1]), p0[2]); mxb = fmaxf(fmaxf(mxb, p1[5]), p0[6]); mxc = fmaxf(fmaxf(mxc, p1[9]), p0[10]); mxd = fmaxf(fmaxf(mxd, p1[13]), p0[14]);
            mxa = fmaxf(fmaxf(mxa, p1[2]), p0[3]); mxb = fmaxf(fmaxf(mxb, p1[6]), p0[7]); mxc = fmaxf(fmaxf(mxc, p1[10]), p0[11]); mxd = fmaxf(fmaxf(mxd, p1[14]), p0[15]);
            mxa = fmaxf(fmaxf(mxa, p1[3]), mxb); mxc = fmaxf(fmaxf(mxc, p1[7]), mxd); float mx = fmaxf(fmaxf(mxa, p1[11]), fmaxf(mxc, p1[15]));
            { const auto rr_ = __builtin_amdgcn_permlane32_swap(__float_as_uint(mx), __float_as_uint(mx), false, false); mx = fmaxf(__uint_as_float(rr_[0]), __uint_as_float(rr_[1])); }
            if (first || __any(mx > THR)) {
                const float dl = first ? mx : fmaxf(mx, 0.f); m_ref += dl;
                if (!first) { const float alpha = __builtin_amdgcn_exp2f(-dl); l_run *= alpha; o0 *= alpha; o1 *= alpha; }
#pragma unroll
                for (int i = 0; i < 16; ++i) { p0[i] -= dl; p1[i] -= dl; }
                first = false;
            }
            float ls0 = 0.f, ls1 = 0.f, ls2 = 0.f, ls3 = 0.f;
#pragma unroll
            for (int i = 0; i < 16; i += 4) {
                p0[i] = __builtin_amdgcn_exp2f(p0[i]); p1[i] = __builtin_amdgcn_exp2f(p1[i]); p0[i + 1] = __builtin_amdgcn_exp2f(p0[i + 1]); p1[i + 1] = __builtin_amdgcn_exp2f(p1[i + 1]);
                p0[i + 2] = __builtin_amdgcn_exp2f(p0[i + 2]); p1[i + 2] = __builtin_amdgcn_exp2f(p1[i + 2]); p0[i + 3] = __builtin_amdgcn_exp2f(p0[i + 3]); p1[i + 3] = __builtin_amdgcn_exp2f(p1[i + 3]);
                ls0 += p0[i] + p1[i]; ls1 += p0[i + 1] + p1[i + 1]; ls2 += p0[i + 2] + p1[i + 2]; ls3 += p0[i + 3] + p1[i + 3]; }
            l_run += (ls0 + ls1) + (ls2 + ls3);
            u32x4 w0, w1, w2, w3;
            w0.x = cvtpk(p0[0], p0[1]); w0.y = cvtpk(p0[2], p0[3]); w0.z = cvtpk(p0[4], p0[5]); w0.w = cvtpk(p0[6], p0[7]);
            w1.x = cvtpk(p0[8], p0[9]); w1.y = cvtpk(p0[10], p0[11]); w1.z = cvtpk(p0[12], p0[13]); w1.w = cvtpk(p0[14], p0[15]);
            w2.x = cvtpk(p1[0], p1[1]); w2.y = cvtpk(p1[2], p1[3]); w2.z = cvtpk(p1[4], p1[5]); w2.w = cvtpk(p1[6], p1[7]);
            w3.x = cvtpk(p1[8], p1[9]); w3.y = cvtpk(p1[10], p1[11]); w3.z = cvtpk(p1[12], p1[13]); w3.w = cvtpk(p1[14], p1[15]);
            const bf16x8 pf0 = __builtin_bit_cast(bf16x8, w0), pf1 = __builtin_bit_cast(bf16x8, w1), pf2 = __builtin_bit_cast(bf16x8, w2), pf3 = __builtin_bit_cast(bf16x8, w3);
            o0 = __builtin_amdgcn_mfma_f32_32x32x16_bf16(vf[0], pf0, o0, 0, 0, 0); o1 = __builtin_amdgcn_mfma_f32_32x32x16_bf16(vf[1], pf0, o1, 0, 0, 0);
            o0 = __builtin_amdgcn_mfma_f32_32x32x16_bf16(vf[2], pf1, o0, 0, 0, 0); o1 = __builtin_amdgcn_mfma_f32_32x32x16_bf16(vf[3], pf1, o1, 0, 0, 0);
            o0 = __builtin_amdgcn_mfma_f32_32x32x16_bf16(vf[4], pf2, o0, 0, 0, 0); o1 = __builtin_amdgcn_mfma_f32_32x32x16_bf16(vf[5], pf2, o1, 0, 0, 0);
            o0 = __builtin_amdgcn_mfma_f32_32x32x16_bf16(vf[6], pf3, o0, 0, 0, 0); o1 = __builtin_amdgcn_mfma_f32_32x32x16_bf16(vf[7], pf3, o1, 0, 0, 0);
        }
        const float l_tot = l_run + __shfl_xor(l_run, 32);
        const float inv = 1.f / l_tot;
        bf16_t* orow = QKVC + qoff + (size_t)q * 64;
        store_o_row(orow, o0, o1, inv, h);
        if (h == 0) *(GAS float*)(LSE + lseoff + (size_t)q * lsepitch) = m_ref + __log2f(l_tot);
        __syncthreads();
        if (!has_next) break;
        L = Ln; qoff = nqoff; koff = nkoff; voff = nvoff; lseoff = nlseoff; lsepitch = nlsepitch; q0 = nq0;
    }
#undef DL_ISSUE
}

DI void sincos_acc(float ang, float& s, float& c) {
    const double x = (double)ang;
    const double k = __builtin_rint(x * 0.63661977236758134);
    double rr = __builtin_fma(-k, 1.5707963267948966, x); rr = __builtin_fma(-k, 6.123233995736766e-17, rr);
    const int qd = ((int)k) & 3;
    const double r2 = rr * rr;
    const double sp = rr * (1.0 + r2 * (-1.0 / 6 + r2 * (1.0 / 120 + r2 * (-1.0 / 5040 + r2 * (1.0 / 362880 + r2 * (-1.0 / 39916800 + r2 * (1.0 / 6227020800.0)))))));
    const double cp = 1.0 + r2 * (-0.5 + r2 * (1.0 / 24 + r2 * (-1.0 / 720 + r2 * (1.0 / 40320 + r2 * (-1.0 / 3628800 + r2 * (1.0 / 479001600 + r2 * (-1.0 / 87178291200.0)))))));
    const double sv = (qd == 0) ? sp : (qd == 1) ? cp : (qd == 2) ? -sp : -cp;
    const double cv = (qd == 0) ? cp : (qd == 1) ? -sp : (qd == 2) ? -cp : sp;
    s = (float)sv; c = (float)cv;
}
DI int perm_dil(int l) { return (l & ~63) | (((l >> 4) & 1) << 5) | (((l >> 2) & 3) << 3) | (((l >> 5) & 1) << 2) | (l & 3); }
DI int perm_r32(int l) { return (l & ~31) | (((l >> 2) & 3) << 3) | (((l >> 4) & 1) << 2) | (l & 3); }
DI void cvt_item(const float* W, int ldw, int col0, int ncols, int K, const float* gain, bf16_t* WT, int row_off, int mode, LAS float* scr, int item, int lane) {
    const int nblk = (ncols + 31) >> 5, kb = item / nblk, nb = item - kb * nblk, k0 = 64 * kb, n0 = 32 * nb;
    const int nn = n0 + (lane & 31); const bool ok = nn < ncols;
#pragma unroll
    for (int i = 0; i < 32; ++i) { const int kk = 2 * i + (lane >> 5); float w = ok ? *(const GAS float*)(W + (size_t)(k0 + kk) * ldw + col0 + nn) : 0.f; if (gain) w *= *(const GAS float*)(gain + k0 + kk); scr[kk * 33 + (lane & 31)] = w; }
    asm volatile("s_waitcnt lgkmcnt(0)" ::: "memory");
    const int c = lane & 7;
#pragma unroll
    for (int j = 0; j < 4; ++j) { const int n = (lane >> 3) + 8 * j, nsrc = n0 + n; const LAS float* s = scr + (8 * c) * 33 + n;
        if (nsrc < ncols) { const int ndst = (mode == 1 && nsrc < 6144) ? perm_dil(nsrc) : (mode == 2 && ((nsrc >> 5) % 3) == 2) ? perm_r32(nsrc) : (mode == 3) ? perm_r32(nsrc) : nsrc;
            u32x4 o; o.x = cvtpk(s[0 * 33], s[1 * 33]); o.y = cvtpk(s[2 * 33], s[3 * 33]); o.z = cvtpk(s[4 * 33], s[5 * 33]); o.w = cvtpk(s[6 * 33], s[7 * 33]);
            *(GAS u32x4*)(WT + (size_t)(row_off + ndst) * K + k0 + 8 * c) = o; } }
    asm volatile("s_waitcnt lgkmcnt(0)" ::: "memory");
}
DI void cvt_job(const float* W, int ldw, int col0, int ncols, int K, const float* gain, bf16_t* WT, int row_off, int mode, LAS float* scr, int gw, int NGW, int lane) {
    const int items = (K >> 6) * ((ncols + 31) >> 5);
    for (int it = gw; it < items; it += NGW) cvt_item(W, ldw, col0, ncols, K, gain, WT, row_off, mode, scr, it, lane);
}
DI void zero_rows(bf16_t* p, size_t nelem, int gt, int NGT) {
    const u32x4 z = {0, 0, 0, 0};
    for (size_t i = (size_t)gt * 8; i < nelem; i += (size_t)NGT * 8) *(GAS u32x4*)(p + i) = z;
}

#define XB_TMO      128
#define XB_XCNT(j)  (256  + 64 * (j))
#define XB_XSUB(j)  (1280 + 64 * (j))
#define XB_XGEN(j)  (2304 + 64 * (j))
#define XB_TOP      3328
#define XB_TOPGEN   3392
#define XCD_BAR_WORDS 3456
#define XB_SPIN_CAP (1u << 18)

__device__ __forceinline__ unsigned xb_ld(unsigned* p)              { return __hip_atomic_load(p, __ATOMIC_RELAXED, __HIP_MEMORY_SCOPE_AGENT); }
__device__ __forceinline__ unsigned xb_add(unsigned* p, unsigned v) { return __hip_atomic_fetch_add(p, v, __ATOMIC_RELAXED, __HIP_MEMORY_SCOPE_AGENT); }
__device__ __forceinline__ unsigned xb_xcc_id() { return (unsigned)__builtin_amdgcn_s_getreg((3 << 11) | 20) & 0xFu; }
#define XB_SPIN(cond, bar) do { unsigned _sp = 0; while (cond) { __builtin_amdgcn_s_sleep(1); \
    if ((++_sp & 255u) == 0u) { if (xb_ld(&(bar)[XB_TMO])) break; if (_sp > XB_SPIN_CAP) { atomicAdd(&(bar)[XB_TMO], 1u); break; } } } } while (0)

struct XcdBarrier {
    unsigned* bar; unsigned x;
    volatile LAS unsigned* st;
};

__device__ __forceinline__ XcdBarrier xcd_barrier_post(unsigned* bar, volatile LAS unsigned* st) {
    XcdBarrier b; b.bar = bar; b.x = xb_xcc_id(); b.st = st;
    if (threadIdx.x == 0) (void)xb_add(&bar[XB_XCNT(b.x)], 1u);
    return b;
}
__device__ __forceinline__ void xcd_barrier_complete(unsigned* bar, unsigned x, unsigned& nloc, unsigned& nx) {
    const unsigned G = gridDim.x * gridDim.y * gridDim.z;
    unsigned sum, cnt, mine, sp = 0u;
    for (;;) {
        sum = 0u; cnt = 0u; mine = 0u;
#pragma unroll
        for (unsigned j = 0; j < 16; ++j) { const unsigned c = xb_ld(&bar[XB_XCNT(j)]); sum += c; cnt += (c > 0u) ? 1u : 0u; mine = (j == x) ? c : mine; }
        if (sum == G) break;
        __builtin_amdgcn_s_sleep(1);
        if ((++sp & 255u) == 0u) { if (xb_ld(&bar[XB_TMO])) break; if (sp > XB_SPIN_CAP) { atomicAdd(&bar[XB_TMO], 1u); break; } }
    }
    nloc = mine > 0u ? mine : 1u; nx = cnt > 0u ? cnt : 1u;
}

__device__ __forceinline__ void xcd_barrier(const XcdBarrier& b) {
    asm volatile("s_waitcnt vmcnt(0)" ::: "memory");
    __syncthreads();
    if (threadIdx.x == 0) {
        unsigned* bar = b.bar;
        __builtin_amdgcn_s_waitcnt(0);
        unsigned nloc = b.st[0], nx = b.st[1];
        if (nloc == 0u) { xcd_barrier_complete(bar, b.x, nloc, nx); b.st[0] = nloc; b.st[1] = nx; }
        const unsigned old = xb_add(&bar[XB_XSUB(b.x)], 1u);
        const unsigned gen = old / nloc;
        if (old + 1u == (gen + 1u) * nloc) {
            __builtin_amdgcn_fence(__ATOMIC_RELEASE, "agent");
            asm volatile("s_waitcnt vmcnt(0)" ::: "memory");
            const unsigned og = xb_add(&bar[XB_TOP], 1u);
            const unsigned tg = og / nx;
            if (og + 1u == (tg + 1u) * nx) xb_add(&bar[XB_TOPGEN], 1u);
            else XB_SPIN(xb_ld(&bar[XB_TOPGEN]) == tg, bar);
            __builtin_amdgcn_fence(__ATOMIC_ACQUIRE, "agent");
            xb_add(&bar[XB_XGEN(b.x)], 1u);
            asm volatile("s_waitcnt vmcnt(0)" ::: "memory");
        } else {
            XB_SPIN(xb_ld(&bar[XB_XGEN(b.x)]) == gen, bar);
            __builtin_amdgcn_fence(__ATOMIC_ACQUIRE, "agent");
            asm volatile("s_waitcnt vmcnt(0)" ::: "memory");
        }
    }
    __syncthreads();
}

DI const float* ldarg(int idx) {
    const float* p; const int off = __builtin_amdgcn_readfirstlane(idx * 8);
    asm volatile("s_load_dwordx2 %0, %1, %2\n\ts_waitcnt lgkmcnt(0)" : "=s"(p) : "s"(__builtin_amdgcn_kernarg_segment_ptr()), "s"(off) : "memory");
    return p;
}
DI void cvt_layer(int layer, bf16_t* WB, u64* SQ, u64* SKV, LAS float* scr, int gw, int NGW, int gt, int NGT, int lane) {
    const int kind = (layer == 3) ? 0 : layer;
    const int b0 = layer == 0 ? 1 : layer == 1 ? 12 : layer == 2 ? 20 : 26;
    for (int i = gt; i < T_TOK; i += NGT) { st_dev(SQ + i, 0.f); st_dev(SKV + i, 0.f); }
    const float* attn_norm = ldarg(b0);
    const int bw = b0 + (kind == 0 ? 7 : kind == 1 ? 4 : 2);
    const float* w_o = ldarg(bw); const float* mlp_norm = ldarg(bw + 1); const float* w_up = ldarg(bw + 2); const float* w_down = ldarg(bw + 3);
#define CJ(W_, ldw_, col0_, ncols_, K_, gain_, WT_, roff_, mode_) { const int n_ = ((K_) >> 6) * (((ncols_) + 31) >> 5); \
        if (r_ < n_) { cvt_item(W_, ldw_, col0_, ncols_, K_, gain_, WT_, roff_, mode_, scr, r_, lane); continue; } r_ -= n_; }
#define CJ_MLP CJ(w_up, 4096, 0, 4096, 1024, mlp_norm, WB + WO_UP, 0, 0) CJ(w_down, 1024, 0, 1024, 4096, nullptr, WB + WO_DOWN, 0, 0) CJ(w_o, 1024, 0, 1024, 1024, nullptr, WB + WO_WO, 0, 0)
    if (kind == 0) {
        const float* wq_a = ldarg(b0 + 1); const float* wkv_a = ldarg(b0 + 4);
        const float* q_norm = ldarg(b0 + 2); const float* wq_b = ldarg(b0 + 3); const float* kv_norm = ldarg(b0 + 5); const float* wkv_b = ldarg(b0 + 6);
        zero_rows(WB + WO_MIX + (size_t)672 * 1024, (size_t)96 * 1024, gt, NGT);
        for (int it = gw; it < 2048 + 2048 + 512 + 128 + 192 + 16 + 288 + 256; it += NGW) { int r_ = it;
            CJ_MLP
            CJ(wkv_a, 288, 0, 256, 1024, attn_norm, WB + WO_MIX, 0, 0) CJ(wq_a, 384, 0, 384, 1024, attn_norm, WB + WO_MIX, 256, 0) CJ(wkv_a, 288, 256, 32, 1024, attn_norm, WB + WO_MIX, 640, 3)
            CJ(wq_b, 1536, 0, 1536, 384, q_norm, WB + WO_QB, 0, 2) CJ(wkv_b, 2048, 0, 2048, 256, kv_norm, WB + WO_KVB, 0, 0) }
    } else if (kind == 1) {
        const float* w_qkv = ldarg(13); const float* w_f = ldarg(14);
        zero_rows(WB + WO_MIX + (size_t)3088 * 1024, (size_t)240 * 1024, gt, NGT);
        for (int it = gw; it < 2048 + 2048 + 512 + 1536 + 16; it += NGW) { int r_ = it;
            CJ_MLP
            CJ(w_qkv, 3072, 0, 3072, 1024, attn_norm, WB + WO_MIX, 0, 0) CJ(w_f, 16, 0, 16, 1024, attn_norm, WB + WO_MIX, 3072, 0) }
    } else {
        const float* w_qkv = ldarg(21);
        for (int it = gw; it < 2048 + 2048 + 512 + 4608; it += NGW) { int r_ = it;
            CJ_MLP
            CJ(w_qkv, 9216, 0, 9216, 1024, attn_norm, WB + WO_MIX, 0, 1) }
    }
#undef CJ
#undef CJ_MLP
}
struct Params { const float* in[38]; float* out; unsigned char* ws; int lo, hi; };

__global__ void __launch_bounds__(512) mega(Params P) {
    extern __shared__ __attribute__((aligned(16))) unsigned char lds_raw[];
    LAS unsigned char* lds = (LAS unsigned char*)lds_raw;
    cg::grid_group grid = cg::this_grid();
    { volatile LAS unsigned* st_ = (volatile LAS unsigned*)(lds + LDS_BYTES - 64); if (threadIdx.x < 2) st_[threadIdx.x] = 0u; }
    __syncthreads();
    XcdBarrier xbar; xbar.bar = (unsigned*)P.ws; xbar.x = 0; xbar.st = (volatile LAS unsigned*)(lds + LDS_BYTES - 64);
    const int G = gridDim.x, NGW = G * 8, NGT = G * 512;
#define IDS const int tid = otid(), lane = tid & 63, wave = __builtin_amdgcn_readfirstlane(tid >> 6), bx = obid(), gw = bx * 8 + wave, gt = bx * 512 + tid; LAS float* scr = (LAS float*)(lds + wave * 16384); (void)lane; (void)gw; (void)gt; (void)scr; \
    unsigned char* ws = P.ws; asm volatile("" : "+s"(ws)); float* H = P.out; asm volatile("" : "+s"(H)); bf16_t* HL = (bf16_t*)H; (void)HL; \
    float* cosM = (float*)(ws + WS_COSM); float* sinM = (float*)(ws + WS_SINM); float* cosD = (float*)(ws + WS_COSD); float* sinD = (float*)(ws + WS_SIND); \
    u64* SSA = (u64*)(ws + WS_P16); u64* SSB = SSA + T_TOK; u64* SQ = SSB + T_TOK; u64* SKV = SQ + T_TOK; \
    bf16_t* WB0 = (bf16_t*)(ws + WS_W); bf16_t* WB1 = (bf16_t*)(ws + WS_W1); bf16_t* HB = (bf16_t*)(ws + WS_HB); unsigned char* R = ws + WS_R; \
    float* LOGF = (float*)(ws + WS_LOGF); float* DLB = (float*)(ws + WS_DL); bf16_t* KPE = (bf16_t*)(ws + WS_KPE); float* LSE = (float*)(ws + WS_LSE); \
    (void)H; (void)cosM; (void)sinM; (void)cosD; (void)sinD; (void)SSA; (void)SSB; (void)SQ; (void)SKV; (void)WB0; (void)WB1; (void)HB; (void)R; (void)LOGF; (void)DLB; (void)KPE; (void)LSE
    const int lo = P.lo, hi = P.hi;
    int ph = 0;
#define PH_ON (ph >= lo && ph < hi)
#define PH_END do { if (ph >= lo && ph + 1 < hi) { if (ph == 0) { grid.sync(); xbar = xcd_barrier_post((unsigned*)P.ws, (volatile LAS unsigned*)(lds + LDS_BYTES - 64)); } else xcd_barrier(xbar); } ++ph; } while (0)

    if (PH_ON) { IDS;
        if (bx == 0) for (int i = tid; i < 4096; i += 512) __hip_atomic_store((unsigned*)ws + i, 0u, __ATOMIC_RELAXED, __HIP_MEMORY_SCOPE_AGENT);
        for (int i = gt; i < SEQ * 16; i += NGT) { const int pos = i >> 4, f = i & 15; float s, c; sincos_acc((float)pos * INV16[f], s, c); *(GAS float*)(cosM + i) = c; *(GAS float*)(sinM + i) = s; }
        for (int i = gt; i < SEQ * 32; i += NGT) { const int pos = i >> 5, f = i & 31; float s, c; sincos_acc((float)pos * INV32[f], s, c); *(GAS float*)(cosD + i) = c; *(GAS float*)(sinD + i) = s; }
        const float* x = ldarg(0);
        for (int row = gw; row < T_TOK; row += NGW) {
            const GAS f32x4* xr = (const GAS f32x4*)(x + (size_t)row * DM) + lane; float ss = 0.f;
#pragma unroll
            for (int j = 0; j < 4; ++j) { const f32x4 v = __builtin_nontemporal_load(xr + 64 * j); ss += dot4(v);     u32x2 hh_, ll_; { const u32x2 s0 = split2(v.x, v.y), s1 = split2(v.z, v.w); hh_.x = s0.x; ll_.x = s0.y; hh_.y = s1.x; ll_.y = s1.y; }
                *(GAS u32x2*)(HB + (size_t)row * DM + 4 * lane + 256 * j) = hh_; if (RES_LO) *(GAS u32x2*)(HL + (size_t)row * DM + 4 * lane + 256 * j) = ll_; }
            ss = wave_sum(ss);
            if (lane == 0) { st_dev(SSB + row, ss); st_dev(SSA + row, 0.f); }
        }
        cvt_layer(0, WB0, SQ, SKV, scr, gw, NGW, gt, NGT, lane);
    }
    PH_END;

#pragma nounroll
    for (int layer = 0; layer < 4; ++layer) {
        const int kind = (layer == 3) ? 0 : layer;
#define WB ((layer & 1) ? WB1 : WB0)
#define Obuf ((bf16_t*)(R + (kind == 0 ? R_O_MLA : kind == 1 ? R_O_FOX : R_O_DIL)))
        if (kind == 0) {
#define CKV ((bf16_t*)(R + R_CKV))
#define CQ ((bf16_t*)(R + R_CQ))
#define Q ((bf16_t*)(R + R_Q))
#define KV ((bf16_t*)(R + R_KV))
            if (PH_ON) { IDS;
                pg8::Gemm g{HB, WB + WO_MIX, T_TOK, 768, 1024}; pg8::StaticOrder S; S.init(T_TOK, 768, G, bx);
                EpiMlaA E{SSB, CKV, CQ, KPE, SQ, SKV, cosM, sinM};
                pg8::gemm_phase<EpiMlaA, pg8::StaticOrder, true, true>(lds, g, S, E);
            }
            PH_END;
            if (PH_ON) { IDS;
                { pg8::Gemm g{CQ, WB + WO_QB, T_TOK, 1536, 384}; pg8::StaticOrder S; S.init(T_TOK, 1536, G, bx);
                  EpiMlaQ E{SQ, Q, cosM, sinM};
                  pg8::gemm_phase<EpiMlaQ, pg8::StaticOrder, true, true>(lds, g, S, E); }
                __syncthreads();
                { pg8::Gemm g{CKV, WB + WO_KVB, T_TOK, 2048, 256}; pg8::StaticOrder S; S.init(T_TOK, 2048, G, bx);
                  EpiMlaKV E{SKV, KV};
                  pg8::gemm_phase<EpiMlaKV, pg8::StaticOrder, true, true>(lds, g, S, E); }
            }
            PH_END;
            if (PH_ON) { IDS;
                u32x4 kreg0 = {0, 0, 0, 0}, kreg1 = kreg0, k2reg = kreg0, vreg0 = kreg0, vreg1 = kreg0; f32x4 dkreg = {0.f, 0.f, 0.f, 0.f}; bool pre = false;
                for (int L = bx; L < 2048; L += G) {
                    const int slot = 7 - (L >> 8), v = L & 255, bh = ((v >> 4) << 3) | (v & 7), p = (v >> 3) & 1, b = bh >> 4, hh = bh & 15;
                    const int base = 4 * (slot >> 1), qb = (slot & 1) ? base + 3 - p : base + p;
                    const size_t t0 = (size_t)b * SEQ;
                    const int Ln = L + G; const bool has_next = Ln < 2048;
                    const int vn = Ln & 255, bhn = ((vn >> 4) << 3) | (vn & 7); const size_t t0n = (size_t)(bhn >> 4) * SEQ; const int hn = bhn & 15;
                    attn_unit<96, 0>(lds, Q + t0 * 1536 + hh * 96, 1536, KV + t0 * 2048 + hh * 128, 2048, KPE + t0 * 32, 32,
                                     KV + t0 * 2048 + hh * 128 + 64, 2048, Obuf + t0 * 1024 + hh * 64, 1024, nullptr, nullptr, 0, qb * 256, 1 << 20,
                                     pre, has_next, KV + t0n * 2048 + hn * 128, KPE + t0n * 32, KV + t0n * 2048 + hn * 128 + 64, nullptr, kreg0, kreg1, k2reg, vreg0, vreg1, dkreg);
                    pre = has_next;
                }
            }
            PH_END;
        } else if (kind == 1) {
#define QKV ((bf16_t*)(R + R_QKV))
            if (PH_ON) { IDS;
                pg8::Gemm g{HB, WB + WO_MIX, T_TOK, 3328, 1024}; pg8::StaticOrder S; S.init(T_TOK, 3328, G, bx);
                EpiFox E{SSB, QKV, LOGF, ldarg(15)};
                pg8::gemm_phase<EpiFox, pg8::StaticOrder, true, true>(lds, g, S, E);
            }
            PH_END;
            if (PH_ON) { IDS;
                for (int sq = gw; sq < 128; sq += NGW) {
                    const float* src = LOGF + (size_t)(sq >> 4) * SEQ * 16 + (sq & 15) + (size_t)(64 * lane) * 16;
                    float s = 0.f;
                    float lv[64];
#pragma unroll
                    for (int i = 0; i < 64; ++i) lv[i] = *(const GAS float*)(src + i * 16);
#pragma unroll
                    for (int i = 0; i < 64; ++i) s += lv[i];
                    float inc = s;
#pragma unroll
                    for (int o = 1; o < 64; o <<= 1) { const float t = __shfl_up(inc, o); if (lane >= o) inc += t; }
                    float run = inc - s; float* dst = DLB + (size_t)sq * SEQ + 64 * lane;
#pragma unroll
                    for (int i = 0; i < 64; ++i) { run += lv[i]; *(GAS float*)(dst + i) = run * LOG2E; }
                }
            }
            PH_END;
            if (PH_ON) { IDS;
                u32x4 kreg0 = {0, 0, 0, 0}, kreg1 = kreg0, k2reg = kreg0, vreg0 = kreg0, vreg1 = kreg0; f32x4 dkreg = {0.f, 0.f, 0.f, 0.f}; bool pre = false;
                for (int L = bx; L < 2048; L += G) {
                    const int slot = 7 - (L >> 8), v = L & 255, bh = ((v >> 4) << 3) | (v & 7), p = (v >> 3) & 1, b = bh >> 4, hh = bh & 15;
                    const int base = 4 * (slot >> 1), qb = (slot & 1) ? base + 3 - p : base + p;
                    const size_t t0 = (size_t)b * SEQ;
                    const int Ln = L + G; const bool has_next = Ln < 2048;
                    const int vn = Ln & 255, bhn = ((vn >> 4) << 3) | (vn & 7); const size_t t0n = (size_t)(bhn >> 4) * SEQ; const int hn = bhn & 15;
                    attn_unit<64, 1>(lds, QKV + t0 * 3072 + hh * 64, 3072, QKV + t0 * 3072 + 1024 + hh * 64, 3072, nullptr, 0,
                                     QKV + t0 * 3072 + 2048 + hh * 64, 3072, Obuf + t0 * 1024 + hh * 64, 1024, DLB + (size_t)bh * SEQ, nullptr, 0, qb * 256, 1 << 20,
                                     pre, has_next, QKV + t0n * 3072 + 1024 + hn * 64, nullptr, QKV + t0n * 3072 + 2048 + hn * 64, DLB + (size_t)bhn * SEQ, kreg0, kreg1, k2reg, vreg0, vreg1, dkreg);
                    pre = has_next;
                }
            }
            PH_END;
        } else {
#define QKVC ((bf16_t*)(R + R_QKV))
#pragma nounroll
            for (int ch = 0; ch < 2; ++ch) {
                const size_t row0 = (size_t)ch * 16384;
                if (PH_ON) { IDS;
                    pg8::Gemm g{HB + row0 * DM, WB + WO_MIX, 16384, 9216, 1024}; pg8::StaticOrder S; S.init(16384, 9216, G, bx);
                    EpiDil E{SSB + row0, QKVC, cosD, sinD};
                    pg8::gemm_phase<EpiDil, pg8::StaticOrder, true, true>(lds, g, S, E);
                }
                PH_END;
                if (PH_ON) { IDS;
                    dil_phase(lds, QKVC, LSE, bx, G);
                }
                PH_END;
                if (PH_ON) { IDS;
                    for (int i = gt; i < 16384 * 128; i += NGT) {
                        const int tok = i >> 7, c8 = i & 127, hd = c8 >> 3;
                        const GAS float* lp = (const GAS float*)(LSE + (size_t)tok * 48 + hd); const float l0 = lp[0], l1 = lp[16], l2 = lp[32];
                        const float mx = fmaxf(l0, fmaxf(l1, l2));
                        float w0 = __builtin_amdgcn_exp2f(l0 - mx), w1 = __builtin_amdgcn_exp2f(l1 - mx), w2 = __builtin_amdgcn_exp2f(l2 - mx);
                        const float iw = 1.f / (w0 + w1 + w2); w0 *= iw; w1 *= iw; w2 *= iw;
                        const int cbl = tok >> 12, ct = tok & 4095, cch = c8 & 7;
                        const size_t r0 = ct, r1 = ((size_t)(ct & 3) << 10) + (ct >> 2), r2 = ((size_t)(ct & 15) << 8) + (ct >> 4);
                        const bf16_t* pl = QKVC + (size_t)((cbl * 9) * 16 + hd) * 4096 * 64 + cch * 8;
                        const u32x4 a = *(const GAS u32x4*)(pl + r0 * 64), b = *(const GAS u32x4*)(pl + ((size_t)16 * 4096 + r1) * 64), c = *(const GAS u32x4*)(pl + ((size_t)32 * 4096 + r2) * 64);
                        u32x4 o;
#pragma unroll
                        for (int e = 0; e < 4; ++e) {
                            const float alo = __uint_as_float(a[e] << 16), ahi = __uint_as_float(a[e] & 0xffff0000u);
                            const float blo = __uint_as_float(b[e] << 16), bhi = __uint_as_float(b[e] & 0xffff0000u);
                            const float clo = __uint_as_float(c[e] << 16), chi = __uint_as_float(c[e] & 0xffff0000u);
                            o[e] = cvtpk(w0 * alo + w1 * blo + w2 * clo, w0 * ahi + w1 * bhi + w2 * chi);
                        }
                        *(GAS u32x4*)(Obuf + (row0 + tok) * 1024 + c8 * 8) = o;
                    }
                }
                PH_END;
            }
        }
        if (PH_ON) { IDS;
            pg8::Gemm g{Obuf, WB + WO_WO, T_TOK, 1024, 1024}; pg8::StaticOrder S; S.init(T_TOK, 1024, G, bx);
            for (int i = gt; i < T_TOK; i += NGT) st_dev(SSB + i, 0.f);
            EpiRes E{HB, HL, HL, SSA};
            pg8::gemm_phase<EpiRes, pg8::StaticOrder, true, true>(lds, g, S, E);
        }
        PH_END;
        if (PH_ON) { IDS;
            pg8::Gemm g{HB, WB + WO_UP, T_TOK, 4096, 1024}; pg8::StaticOrder S; S.init(T_TOK, 4096, G, bx);
            EpiUp E{SSA, (bf16_t*)(R + R_U)};
            pg8::gemm_phase<EpiUp, pg8::StaticOrder, true, true>(lds, g, S, E);
        }
        PH_END;
        if (PH_ON) { IDS;
            pg8::Gemm g{(const bf16_t*)(R + R_U), WB + WO_DOWN, T_TOK, 1024, 4096}; pg8::StaticOrder S; S.init(T_TOK, 1024, G, bx);
            for (int i = gt; i < T_TOK; i += NGT) st_dev(SSA + i, 0.f);
            if (layer < 3) { cvt_layer(layer + 1, (layer & 1) ? WB0 : WB1, SQ, SKV, scr, gw, NGW, gt, NGT, lane); __syncthreads(); }
            EpiRes E{HB, HL, (layer == 3) ? (bf16_t*)(R + 256 * MiB) : HL, SSB};
            pg8::gemm_phase<EpiRes, pg8::StaticOrder, true, true>(lds, g, S, E);
        }
        PH_END;
    }
    if (PH_ON) { IDS;
        const float* gain = ldarg(37);
        for (int row = gw; row < T_TOK; row += NGW) {
            const float rs = rsqrtf(ld_dev(SSB + row) * (1.f / 1024.f) + EPS);
            const GAS u32x2* hp = (const GAS u32x2*)(HB + (size_t)row * DM) + lane; const GAS u32x2* lp = (const GAS u32x2*)((const bf16_t*)(R + 256 * MiB) + (size_t)row * DM) + lane;
            GAS f32x4* orow = (GAS f32x4*)(H + (size_t)row * DM) + lane; const GAS f32x4* gr = (const GAS f32x4*)gain + lane;
#pragma unroll
            for (int j = 0; j < 4; ++j) { const u32x2 hh_ = hp[64 * j], ll_ = RES_LO ? lp[64 * j] : (u32x2){0u, 0u}; const f32x4 gq = gr[64 * j];
                f32x4 v = {bflo(hh_.x) + bflo(ll_.x), bfhi(hh_.x) + bfhi(ll_.x), bflo(hh_.y) + bflo(ll_.y), bfhi(hh_.y) + bfhi(ll_.y)};
                orow[64 * j] = v * rs * gq; }
        }
    }
    PH_END;
#undef PH_ON
#undef PH_END
}

constexpr int N_PHASES = 1 + 6 + 6 + 9 + 6 + 1;
#ifndef MK_COOP
#define MK_COOP 1
#endif

extern "C" void kernel_launch(void* const* d_in, const int* in_sizes, int n_in, void* d_out, int out_size, void* d_ws, size_t ws_size, hipStream_t stream) {
    static int grid = 0;
    if (grid == 0) {
        if (n_in != 38 || out_size != T_TOK * DM || ws_size < WS_NEED) { fprintf(stderr, "kernel_launch: unexpected shapes (n_in %d out %d ws %zu)\n", n_in, out_size, ws_size); grid = -1; return; }
        int dev = 0, cus = 0, per_cu = 0;
        hipGetDevice(&dev); hipDeviceGetAttribute(&cus, hipDeviceAttributeMultiprocessorCount, dev);
        if (hipFuncSetAttribute((const void*)mega, hipFuncAttributeMaxDynamicSharedMemorySize, LDS_BYTES) != hipSuccess) { fprintf(stderr, "kernel_launch: hipFuncSetAttribute failed\n"); grid = -1; return; }
        if (hipOccupancyMaxActiveBlocksPerMultiprocessor(&per_cu, (const void*)mega, 512, LDS_BYTES) != hipSuccess || per_cu < 1) per_cu = 1;
        (void)hipGetLastError();
        grid = cus * per_cu;
        if (grid <= 0) grid = 256;
    }
    if (grid < 0) return;
    Params p{};
    for (int i = 0; i < 38; ++i) p.in[i] = (const float*)d_in[i];
    p.out = (float*)d_out; p.ws = (unsigned char*)d_ws;
#if MK_COOP
    p.lo = 0; p.hi = N_PHASES;
    void* args[] = {&p};
    hipError_t e = hipLaunchCooperativeKernel((const void*)mega, dim3(grid), dim3(512), args, LDS_BYTES, stream);
    if (e != hipSuccess) fprintf(stderr, "cooperative launch failed: %s (grid %d)\n", hipGetErrorString(e), grid);
#else
    for (int k = 0; k < N_PHASES; ++k) { p.lo = k; p.hi = k + 1; hipLaunchKernelGGL(mega, dim3(grid), dim3(512), LDS_BYTES, stream, p); }
#endif
}
```

```cpp
#include <hip/hip_runtime.h>
#include <hip/hip_cooperative_groups.h>
#include <cstdio>
#include <cstdint>
namespace cg = cooperative_groups;
namespace pg8 {
#define PG8_LAS __attribute__((address_space(3)))
typedef unsigned short bf16_t;
typedef short bf16x8 __attribute__((ext_vector_type(8)));
typedef float f32x4 __attribute__((ext_vector_type(4)));
typedef unsigned u32x4 __attribute__((ext_vector_type(4)));
constexpr int BM = 256, BK = 64, HALF = 128, HTB = HALF * BK * 2  , STAGE_BYTES = 8 * HTB, NXCD = 8, WGM = 8;

__host__ __device__ __forceinline__ int lds_byte(int r, int c) { const int st = (r >> 4) * 2 + (c >> 5), rr = r & 15, cc = c & 31, ob = rr * 64 + cc * 2; return st * 1024 + (ob ^ (((ob >> 9) & 1) << 5)); }
__host__ __device__ __forceinline__ void stage_rc(int b, int& R, int& C) { const int st = b / 1024, sb = b % 1024, swz = sb ^ (((sb >> 9) & 1) << 5); R = (st >> 1) * 16 + swz / 64; C = (st & 1) * 32 + (swz % 64) / 2; }
__host__ __device__ __forceinline__ int perm32(int rho) { const int n = rho >> 4, i = rho & 15; return 8 * (i >> 2) + 4 * n + (i & 3); }

struct Unit { int pm, pn; };
struct Gemm { const bf16_t* A; const bf16_t* Bt; int M, N, K; };

struct StaticOrder {
    int nM, nN, nwg, G, c;
    __host__ __device__ void init(int M, int N, int G_, int c_) { nM = M / BM; nN = N / BM; nwg = nM * nN; G = G_; c = c_; }
    __host__ __device__ bool next(int i, Unit& u) const {
        const long L = (long)i * G + c; if (L >= nwg) return false;
        int wgid = (int)L; { const int q = nwg / NXCD, r = nwg % NXCD, xcd = wgid % NXCD, off = wgid / NXCD; wgid = (xcd < r ? xcd * (q + 1) : r * (q + 1) + (xcd - r) * q) + off; }
        const int nig = WGM * nN, gid = wgid / nig, fm = gid * WGM, gsz = (nM - fm) < WGM ? (nM - fm) : WGM;
        u.pm = fm + ((wgid % nig) % gsz); u.pn = (wgid % nig) / gsz; return true;
    }
    __device__ __forceinline__ void a_ready(const Unit&) const {}
    __device__ __forceinline__ void done(const Unit&) const {}
};
__device__ __forceinline__ unsigned cvt_pk_bf16(float lo, float hi) { unsigned r; asm volatile("v_cvt_pk_bf16_f32 %0, %1, %2" : "=v"(r) : "v"(lo), "v"(hi)); return r; }
template <class Epi, class Sched, bool ALIGN_EPI = false, bool SP2 = false>
__device__ __forceinline__ void gemm_phase(PG8_LAS unsigned char* lds, const Gemm g, const Sched& S, const Epi& E) {
    int tid_o = threadIdx.x; asm volatile("" : "+v"(tid_o));
    const int tid = tid_o, wid = __builtin_amdgcn_readfirstlane(tid >> 6), lane = tid & 63, wr = wid >> 2, wc = wid & 3, fr = lane & 15, fq = lane >> 4;
    const int K = g.K, nt = K / BK;
    unsigned voffA[2], voffB[2];
#pragma unroll
    for (int i = 0; i < 2; ++i) { int R, C; stage_rc(tid * 16 + i * 8192, R, C); const int Rb = Epi::PERM ? ((R & ~31) + perm32(R & 31)) : R;
        voffA[i] = (unsigned)(R * K + C) * 2u; voffB[i] = (unsigned)(Rb * K + C) * 2u; }
    const size_t kstep = (size_t)(BK * 2);
    const size_t hstep = (size_t)HALF * K * 2;
    const size_t tstep = 2 * hstep;
    const unsigned ldsw = (unsigned)wid * 1024u;
    const int aoff = lds_byte(wr * 64 + fr, fq * 8), boff = lds_byte(wc * 32 + fr, fq * 8);
#define PG8_SA(b, h) (((b) * 2 + (h)) * HTB)
#define PG8_SB(b, h) ((4 + (b) * 2 + (h)) * HTB)
#define PG8_STAGE(bufoff, gbase, voff) do { _Pragma("unroll") for (int _i = 0; _i < 2; ++_i) \
        __builtin_amdgcn_global_load_lds((const unsigned*)((const char*)(gbase) + (voff)[_i]), (PG8_LAS unsigned*)(lds + (bufoff) + ldsw + _i * 8192), 16, 0, 0); } while (0)
#define PG8_LDA(dst, b, h) do { _Pragma("unroll") for (int m = 0; m < 4; ++m) _Pragma("unroll") for (int k = 0; k < 2; ++k) dst[m][k] = *(const PG8_LAS bf16x8*)(lds + PG8_SA(b, h) + aoff + m * 2048 + k * 1024); } while (0)
#define PG8_LDB(dst, b, h) do { _Pragma("unroll") for (int n = 0; n < 2; ++n) _Pragma("unroll") for (int k = 0; k < 2; ++k) dst[n][k] = *(const PG8_LAS bf16x8*)(lds + PG8_SB(b, h) + boff + n * 2048 + k * 1024); } while (0)
#define PG8_MMA(ai, bj, At, Bt) do { __builtin_amdgcn_s_setprio(1); _Pragma("unroll") for (int m = 0; m < 4; ++m) _Pragma("unroll") for (int n = 0; n < 2; ++n) _Pragma("unroll") for (int k = 0; k < 2; ++k) \
        acc[ai][bj][m][n] = __builtin_amdgcn_mfma_f32_16x16x32_bf16(Bt[n][k], At[m][k], acc[ai][bj][m][n], 0, 0, 0); __builtin_amdgcn_s_setprio(0); } while (0)
#define PG8_WAIT_V(n) asm volatile("s_waitcnt vmcnt(" #n ")" ::: "memory")
#define PG8_WAIT_L(n) asm volatile("s_waitcnt lgkmcnt(" #n ")" ::: "memory")
#define PG8_BAR __builtin_amdgcn_s_barrier()
#define PG8_SCHED __builtin_amdgcn_sched_barrier(0)
    Unit cur, nxt; int ui = 0;
    if (!S.next(0, cur)) return;
    f32x4 acc[2][2][4][2];
#pragma unroll
    for (int a = 0; a < 2; ++a)
#pragma unroll
        for (int b = 0; b < 2; ++b)
#pragma unroll
            for (int m = 0; m < 4; ++m)
#pragma unroll
                for (int n = 0; n < 2; ++n) acc[a][b][m][n] = (f32x4){0.f, 0.f, 0.f, 0.f};
    bf16x8 At[4][2], B0[2][2], B1[2][2];
    const char* cA = (const char*)g.A + (size_t)cur.pm * tstep; const char* cB = (const char*)g.Bt + (size_t)cur.pn * tstep;
    S.a_ready(cur);
    if constexpr (SP2) {
        PG8_STAGE(PG8_SB(0, 0), cB, voffB); PG8_STAGE(PG8_SB(0, 1), cB + hstep, voffB); PG8_STAGE(PG8_SA(0, 0), cA, voffA); PG8_STAGE(PG8_SA(0, 1), cA + hstep, voffA);
        if (wr == 1) PG8_BAR;
        PG8_WAIT_V(2); PG8_BAR;
        PG8_STAGE(PG8_SB(1, 0), cB + kstep, voffB); PG8_STAGE(PG8_SA(1, 0), cA + kstep, voffA); PG8_STAGE(PG8_SB(1, 1), cB + hstep + kstep, voffB);
        PG8_WAIT_V(6); PG8_BAR;
    } else {
        PG8_STAGE(PG8_SB(0, 0), cB, voffB); PG8_STAGE(PG8_SA(0, 0), cA, voffA); PG8_STAGE(PG8_SB(0, 1), cB + hstep, voffB); PG8_STAGE(PG8_SA(0, 1), cA + hstep, voffA);
        if (wr == 1) PG8_BAR;
        PG8_WAIT_V(4); PG8_BAR;
        PG8_STAGE(PG8_SB(1, 0), cB + kstep, voffB); PG8_STAGE(PG8_SA(1, 0), cA + kstep, voffA); PG8_STAGE(PG8_SB(1, 1), cB + hstep + kstep, voffB);
        PG8_WAIT_V(6); PG8_BAR;
    }
    for (;;) {
        const bool has_next = S.next(ui + 1, nxt);
        const char* nA = has_next ? (const char*)g.A + (size_t)nxt.pm * tstep : cA; const char* nB = has_next ? (const char*)g.Bt + (size_t)nxt.pn * tstep : cB;
#pragma nounroll
        for (int t = 0; t < nt; t += 2) {
            const bool last = (t == nt - 2);
            const char* a1 = cA + (size_t)(t + 1) * kstep;
            const char* a2 = last ? nA : cA + (size_t)(t + 2) * kstep; const char* b2 = last ? nB : cB + (size_t)(t + 2) * kstep;
            const char* a3 = a2 + kstep; const char* b3 = b2 + kstep;
            if (last && has_next) S.a_ready(nxt);
            if constexpr (SP2) {
            PG8_LDB(B0, 0, 0); PG8_LDB(B1, 0, 1); PG8_SCHED; PG8_LDA(At, 0, 0); PG8_STAGE(PG8_SA(1, 1), a1 + hstep, voffA);
            PG8_WAIT_V(8); PG8_WAIT_L(0); PG8_BAR; PG8_MMA(0, 0, At, B0); PG8_MMA(0, 1, At, B1); PG8_BAR; PG8_SCHED;
            PG8_LDA(At, 0, 1); PG8_STAGE(PG8_SB(0, 0), b2, voffB); PG8_STAGE(PG8_SB(0, 1), b2 + hstep, voffB); PG8_STAGE(PG8_SA(0, 0), a2, voffA);
            PG8_WAIT_V(8); PG8_WAIT_L(0); PG8_BAR; PG8_MMA(1, 0, At, B0); PG8_MMA(1, 1, At, B1); PG8_BAR; PG8_SCHED;
            PG8_LDB(B0, 1, 0); PG8_LDB(B1, 1, 1); PG8_SCHED; PG8_LDA(At, 1, 0); PG8_STAGE(PG8_SA(0, 1), a2 + hstep, voffA);
            PG8_WAIT_V(8); PG8_WAIT_L(0); PG8_BAR; PG8_MMA(0, 0, At, B0); PG8_MMA(0, 1, At, B1); PG8_BAR; PG8_SCHED;
            PG8_LDA(At, 1, 1); PG8_STAGE(PG8_SB(1, 0), b3, voffB); PG8_STAGE(PG8_SB(1, 1), b3 + hstep, voffB); PG8_STAGE(PG8_SA(1, 0), a3, voffA);
            PG8_WAIT_V(8); PG8_WAIT_L(0); PG8_BAR; PG8_MMA(1, 0, At, B0); PG8_MMA(1, 1, At, B1); PG8_BAR; PG8_SCHED;
            } else {
            PG8_LDB(B0, 0, 0); PG8_SCHED; PG8_LDA(At, 0, 0); PG8_STAGE(PG8_SA(1, 1), a1 + hstep, voffA);
            PG8_WAIT_L(8); PG8_BAR; PG8_WAIT_L(0); PG8_MMA(0, 0, At, B0); PG8_BAR; PG8_SCHED;
            PG8_LDB(B1, 0, 1); PG8_STAGE(PG8_SB(0, 0), b2, voffB);
            PG8_BAR; PG8_WAIT_L(0); PG8_MMA(0, 1, At, B1); PG8_BAR;
            PG8_LDA(At, 0, 1); PG8_STAGE(PG8_SA(0, 0), a2, voffA);
            PG8_BAR; PG8_WAIT_L(0); PG8_MMA(1, 0, At, B0); PG8_BAR; PG8_SCHED;
            PG8_STAGE(PG8_SB(0, 1), b2 + hstep, voffB);
            PG8_WAIT_V(6); PG8_BAR; PG8_MMA(1, 1, At, B1); PG8_BAR;
            PG8_LDB(B0, 1, 0); PG8_SCHED; PG8_LDA(At, 1, 0); PG8_STAGE(PG8_SA(0, 1), a2 + hstep, voffA);
            PG8_WAIT_L(8); PG8_BAR; PG8_WAIT_L(0); PG8_MMA(0, 0, At, B0); PG8_BAR; PG8_SCHED;
            PG8_LDB(B1, 1, 1); PG8_STAGE(PG8_SB(1, 0), b3, voffB);
            PG8_BAR; PG8_WAIT_L(0); PG8_MMA(0, 1, At, B1); PG8_BAR;
            PG8_LDA(At, 1, 1); PG8_STAGE(PG8_SA(1, 0), a3, voffA);
            PG8_BAR; PG8_WAIT_L(0); PG8_MMA(1, 0, At, B0); PG8_BAR; PG8_SCHED;
            PG8_STAGE(PG8_SB(1, 1), b3 + hstep, voffB);
            PG8_WAIT_V(6); PG8_BAR; PG8_MMA(1, 1, At, B1); PG8_BAR;
            }
        }
        if constexpr (ALIGN_EPI) { if (wr == 0) PG8_BAR; }
        if constexpr (!Epi::AFTER_DRAIN) { E(acc, cur, wr, wc, fr, fq); S.done(cur); }
        if (!has_next) break;
#pragma unroll
        for (int a = 0; a < 2; ++a)
#pragma unroll
            for (int b = 0; b < 2; ++b)
#pragma unroll
                for (int m = 0; m < 4; ++m)
#pragma unroll
                    for (int n = 0; n < 2; ++n) acc[a][b][m][n] = (f32x4){0.f, 0.f, 0.f, 0.f};
        cur = nxt; cA = nA; cB = nB; ++ui;
        if constexpr (ALIGN_EPI) { if (wr == 1) PG8_BAR; }
    }
    PG8_WAIT_V(0);
    if constexpr (!ALIGN_EPI) { if (wr == 0) PG8_BAR; }
    PG8_BAR;
    if constexpr (Epi::AFTER_DRAIN) { E.fused(acc, cur, wr, wc, fr, fq, lds, wid, lane); S.done(cur); }
#undef PG8_SA
#undef PG8_SB
#undef PG8_STAGE
#undef PG8_LDA
#undef PG8_LDB
#undef PG8_MMA
#undef PG8_WAIT_V
#undef PG8_WAIT_L
#undef PG8_BAR
#undef PG8_SCHED
}
}

#define LAS __attribute__((address_space(3)))
typedef unsigned short bf16_t;
typedef short bf16x8 __attribute__((ext_vector_type(8)));
typedef float f32x4 __attribute__((ext_vector_type(4)));
typedef float f32x2 __attribute__((ext_vector_type(2)));
typedef float f32x16 __attribute__((ext_vector_type(16)));
typedef unsigned u32x4 __attribute__((ext_vector_type(4)));
typedef unsigned u32x2 __attribute__((ext_vector_type(2)));
#define DI __device__ __forceinline__
#define GAS __attribute__((address_space(1)))

constexpr int T_TOK = 32768, DM = 1024, SEQ = 4096, NB = 8, DFF = 4096;
constexpr float EPS = 1e-6f;
constexpr float LOG2E = 1.4426950408889634f;
constexpr float QS_MLA = 0.10206207261596577f * 1.4426950408889634f;
constexpr float QS_64 = 0.125f * 1.4426950408889634f;

constexpr size_t MiB = 1u << 20;
constexpr size_t WS_COSM = 1 * MiB, WS_SINM = WS_COSM + 256 * 1024, WS_COSD = WS_SINM + 256 * 1024, WS_SIND = WS_COSD + 512 * 1024;
constexpr size_t WS_P16 = 3 * MiB;
constexpr size_t WS_PQ = 5 * MiB;
constexpr size_t WS_PKV = 6 * MiB;
constexpr size_t WS_W = 8 * MiB;
constexpr size_t WS_W1 = 474 * MiB;
constexpr size_t WS_HB = 48 * MiB;
constexpr size_t WS_R = 112 * MiB;
constexpr size_t WS_X0 = 464 * MiB;
constexpr size_t WS_LOGF = WS_X0;
constexpr size_t WS_DL = WS_X0 + 2 * MiB;
constexpr size_t WS_KPE = WS_X0 + 4 * MiB;
constexpr size_t WS_LSE = WS_X0 + 6 * MiB;
constexpr size_t WS_NEED = 510 * MiB;
constexpr size_t WO_MIX = 0, WO_QB = 786432, WO_KVB = 1376256, WO_WO = 9437184, WO_UP = 10485760, WO_DOWN = 14680064;
constexpr size_t R_CKV = 0, R_CQ = 16 * MiB, R_Q = 40 * MiB, R_KV = 136 * MiB, R_O_MLA = 264 * MiB;
constexpr size_t R_QKV = 0, R_O_FOX = 192 * MiB, R_O_DIL = 288 * MiB, R_U = 0;

constexpr int LDS_BYTES = 147456;
constexpr bool RES_LO = false;

__device__ const float INV16[16] = {1.000000000e+00f, 5.623413324e-01f, 3.162277639e-01f, 1.778279394e-01f, 1.000000015e-01f, 5.623412877e-02f, 3.162277862e-02f, 1.778279431e-02f, 9.999999776e-03f, 5.623413250e-03f, 3.162277862e-03f, 1.778279431e-03f, 1.000000047e-03f, 5.623413017e-04f, 3.162277862e-04f, 1.778279402e-04f};
__device__ const float INV32[32] = {1.000000000e+00f, 7.498942018e-01f, 5.623413324e-01f, 4.216965139e-01f, 3.162277639e-01f, 2.371373922e-01f, 1.778279394e-01f, 1.333521456e-01f, 1.000000015e-01f, 7.498941571e-02f, 5.623412877e-02f, 4.216964915e-02f, 3.162277862e-02f, 2.371373586e-02f, 1.778279431e-02f, 1.333521493e-02f, 9.999999776e-03f, 7.498942316e-03f, 5.623413250e-03f, 4.216964822e-03f, 3.162277862e-03f, 2.371373819e-03f, 1.778279431e-03f, 1.333521446e-03f, 1.000000047e-03f, 7.498941850e-04f, 5.623413017e-04f, 4.216965463e-04f, 3.162277862e-04f, 2.371373848e-04f, 1.778279402e-04f, 1.333521504e-04f};

typedef __bf16 bf16x2_t __attribute__((ext_vector_type(2)));
DI unsigned cvtpk(float lo, float hi) { const f32x2 v = {lo, hi}; const bf16x2_t b = __builtin_convertvector(v, bf16x2_t); return __builtin_bit_cast(unsigned, b); }
DI void st_bf16x4(bf16_t* p, f32x4 v) { u32x2 w; w.x = cvtpk(v.x, v.y); w.y = cvtpk(v.z, v.w); *(GAS u32x2*)p = w; }
DI f32x4 ldg4(const float* p) { return *(const GAS f32x4*)p; }
DI void stg4(float* p, f32x4 v) { *(GAS f32x4*)p = v; }
DI float dot4(f32x4 v) { return (v.x * v.x + v.y * v.y) + (v.z * v.z + v.w * v.w); }
DI float quad_sum(float s) { s += __shfl_xor(s, 16); s += __shfl_xor(s, 32); return s; }
DI float sum_part(const float* p, int n4) { float s = 0.f; for (int i = 0; i < n4; ++i) { const f32x4 v = ((const f32x4*)p)[i]; s += (v.x + v.y) + (v.z + v.w); } return s; }
DI float wave_sum(float v) {
#pragma unroll
    for (int o = 1; o < 64; o <<= 1) v += __shfl_xor(v, o);
    return v;
}

DI int otid() { int t = threadIdx.x; asm volatile("" : "+v"(t)); return t; }
DI int obid() { int b = blockIdx.x; asm volatile("" : "+s"(b)); return b; }
typedef f32x4 Acc[2][2][4][2];
#define EROW(ai, m) (u.pm * 256 + (ai) * 128 + wr * 64 + (m) * 16 + fr)
#define ECOL(bj, n) (u.pn * 256 + (bj) * 128 + wc * 32 + (n) * 16 + fq * 4)
#define EFENCE() asm volatile("" ::: "memory")

typedef unsigned long long u64;
constexpr float FX_SCALE = 1048576.f, FX_INV = 1.f / 1048576.f;
DI float ld_dev(const u64* p) { return (float)__hip_atomic_load(p, __ATOMIC_RELAXED, __HIP_MEMORY_SCOPE_AGENT) * FX_INV; }
DI void st_dev(u64* p, float v) { __hip_atomic_store(p, (u64)(v * FX_SCALE), __ATOMIC_RELAXED, __HIP_MEMORY_SCOPE_AGENT); }
DI void atomic_addf(u64* p, float v) { __hip_atomic_fetch_add(p, (u64)(v * FX_SCALE), __ATOMIC_RELAXED, __HIP_MEMORY_SCOPE_AGENT); }
DI void st_bf16x8(bf16_t* p, f32x4 a, f32x4 b) { u32x4 w; w.x = cvtpk(a.x, a.y); w.y = cvtpk(a.z, a.w); w.z = cvtpk(b.x, b.y); w.w = cvtpk(b.z, b.w); *(GAS u32x4*)p = w; }
DI float bflo(unsigned w) { return __uint_as_float(w << 16); }
DI float bfhi(unsigned w) { return __uint_as_float(w & 0xffff0000u); }
DI u32x2 split2(float a, float b) { u32x2 r; r.x = cvtpk(a, b); r.y = cvtpk(a - bflo(r.x), b - bfhi(r.x)); return r; }
#define ECOLP(bj) (u.pn * 256 + (bj) * 128 + wc * 32 + fq * 8)
struct EpiRes {
    static constexpr bool PERM = true, AFTER_DRAIN = false;
    bf16_t* hi; const bf16_t* lo_in; bf16_t* lo_out; u64* ssq;
    DI void operator()(const Acc& acc, const pg8::Unit& u, int wr, int wc, int fr, int fq) const {
#pragma unroll
        for (int ai = 0; ai < 2; ++ai)
#pragma unroll
          for (int mh = 0; mh < 2; ++mh) {
            u32x4 hh[2][2], ll[2][2];
#pragma unroll
            for (int m2 = 0; m2 < 2; ++m2)
#pragma unroll
                for (int bj = 0; bj < 2; ++bj) { const size_t off = (size_t)EROW(ai, 2 * mh + m2) * DM + ECOLP(bj); hh[m2][bj] = *(const GAS u32x4*)(hi + off); ll[m2][bj] = RES_LO ? *(const GAS u32x4*)(lo_in + off) : (u32x4){0u, 0u, 0u, 0u}; }
#pragma unroll
            for (int m2 = 0; m2 < 2; ++m2) {
                const int m = 2 * mh + m2;
                const size_t row = EROW(ai, m); float ss = 0.f;
#pragma unroll
                for (int bj = 0; bj < 2; ++bj) {
                    const size_t off = row * DM + ECOLP(bj);
                    const u32x4 H = hh[m2][bj], L = ll[m2][bj]; const f32x4 a0 = acc[ai][bj][m][0], a1 = acc[ai][bj][m][1];
                    float v[8];
                    v[0] = bflo(H.x) + bflo(L.x) + a0.x; v[1] = bfhi(H.x) + bfhi(L.x) + a0.y; v[2] = bflo(H.y) + bflo(L.y) + a0.z; v[3] = bfhi(H.y) + bfhi(L.y) + a0.w;
                    v[4] = bflo(H.z) + bflo(L.z) + a1.x; v[5] = bfhi(H.z) + bfhi(L.z) + a1.y; v[6] = bflo(H.w) + bflo(L.w) + a1.z; v[7] = bfhi(H.w) + bfhi(L.w) + a1.w;
                    u32x4 nh, nl;
                    { const u32x2 s0 = split2(v[0], v[1]), s1 = split2(v[2], v[3]), s2 = split2(v[4], v[5]), s3 = split2(v[6], v[7]); nh.x = s0.x; nl.x = s0.y; nh.y = s1.x; nl.y = s1.y; nh.z = s2.x; nl.z = s2.y; nh.w = s3.x; nl.w = s3.y; }
                    *(GAS u32x4*)(hi + off) = nh; if (RES_LO) *(GAS u32x4*)(lo_out + off) = nl;
#pragma unroll
                    for (int k = 0; k < 8; ++k) ss += v[k] * v[k];
                }
                ss = quad_sum(ss);
                if (fq == 0) atomic_addf(ssq + row, ss);
            }
        }
    }
};
struct EpiUp {
    static constexpr bool PERM = true, AFTER_DRAIN = false;
    const u64* ssq; bf16_t* out;
    DI void operator()(const Acc& acc, const pg8::Unit& u, int wr, int wc, int fr, int fq) const {
        float rs[2][4];
#pragma unroll
        for (int ai = 0; ai < 2; ++ai)
#pragma unroll
            for (int m = 0; m < 4; ++m) rs[ai][m] = ld_dev(ssq + EROW(ai, m));
#pragma unroll
        for (int ai = 0; ai < 2; ++ai)
#pragma unroll
            for (int m = 0; m < 4; ++m) {
                const size_t row = EROW(ai, m);
                const float r = rsqrtf(rs[ai][m] * (1.f / 1024.f) + EPS);
#pragma unroll
                for (int bj = 0; bj < 2; ++bj) {
                    f32x4 v0 = acc[ai][bj][m][0] * r, v1 = acc[ai][bj][m][1] * r;
                    v0.x = fmaxf(v0.x, 0.f); v0.y = fmaxf(v0.y, 0.f); v0.z = fmaxf(v0.z, 0.f); v0.w = fmaxf(v0.w, 0.f);
                    v1.x = fmaxf(v1.x, 0.f); v1.y = fmaxf(v1.y, 0.f); v1.z = fmaxf(v1.z, 0.f); v1.w = fmaxf(v1.w, 0.f);
                    st_bf16x8(out + row * DFF + ECOLP(bj), v0 * v0, v1 * v1);
                }
            }
    }
};
struct EpiMlaA {
    static constexpr bool PERM = true, AFTER_DRAIN = false;
    const u64* ssq; bf16_t* ckv; bf16_t* cq; bf16_t* kpe; u64* sq; u64* skv; const float* cosM; const float* sinM;
    DI void operator()(const Acc& acc, const pg8::Unit& u, int wr, int wc, int fr, int fq) const {
        float rsv[2][4];
#pragma unroll
        for (int ai = 0; ai < 2; ++ai)
#pragma unroll
            for (int m = 0; m < 4; ++m) rsv[ai][m] = ld_dev(ssq + EROW(ai, m));
#pragma unroll
        for (int ai = 0; ai < 2; ++ai)
#pragma unroll
            for (int m = 0; m < 4; ++m) {
                const size_t row = EROW(ai, m);
                const float rs = rsqrtf(rsv[ai][m] * (1.f / 1024.f) + EPS);
                float ss = 0.f;
                if (u.pn == 0) {
#pragma unroll
                    for (int bj = 0; bj < 2; ++bj) { const f32x4 v0 = acc[ai][bj][m][0] * rs, v1 = acc[ai][bj][m][1] * rs; ss += dot4(v0) + dot4(v1); st_bf16x8(ckv + row * 256 + bj * 128 + wc * 32 + fq * 8, v0, v1); }
                    ss = quad_sum(ss); if (fq == 0) atomic_addf(skv + row, ss);
                } else if (u.pn == 1) {
#pragma unroll
                    for (int bj = 0; bj < 2; ++bj) { const f32x4 v0 = acc[ai][bj][m][0] * rs, v1 = acc[ai][bj][m][1] * rs; ss += dot4(v0) + dot4(v1); st_bf16x8(cq + row * 384 + bj * 128 + wc * 32 + fq * 8, v0, v1); }
                    ss = quad_sum(ss); if (fq == 0) atomic_addf(sq + row, ss);
                } else {
                    { const f32x4 v0 = acc[ai][0][m][0] * rs, v1 = acc[ai][0][m][1] * rs; ss += dot4(v0) + dot4(v1); st_bf16x8(cq + row * 384 + 256 + wc * 32 + fq * 8, v0, v1); }
                    ss = quad_sum(ss); if (fq == 0) atomic_addf(sq + row, ss);
                    if (wc == 0) {
                        const int pos = (int)(row & (SEQ - 1));
                        const f32x4 c = ldg4(cosM + pos * 16 + fq * 4), s = ldg4(sinM + pos * 16 + fq * 4);
                        const f32x4 x1 = acc[ai][1][m][0] * rs, x2 = acc[ai][1][m][1] * rs;
                        st_bf16x8(kpe + row * 32 + fq * 8, x1 * c - x2 * s, x1 * s + x2 * c);
                    }
                }
            }
    }
};
struct EpiMlaQ {
    static constexpr bool PERM = true, AFTER_DRAIN = false;
    const u64* sq; bf16_t* Q; const float* cosM; const float* sinM;
    DI void operator()(const Acc& acc, const pg8::Unit& u, int wr, int wc, int fr, int fq) const {
        float rsv[2][4];
#pragma unroll
        for (int ai = 0; ai < 2; ++ai)
#pragma unroll
            for (int m = 0; m < 4; ++m) rsv[ai][m] = ld_dev(sq + EROW(ai, m));
#pragma unroll
        for (int ai = 0; ai < 2; ++ai)
#pragma unroll
            for (int m = 0; m < 4; ++m) {
                const size_t row = EROW(ai, m);
                const float rs = rsqrtf(rsv[ai][m] * (1.f / 384.f) + EPS) * QS_MLA;
                const int toff = (int)(row & (SEQ - 1)) * 16 + fq * 4;
#pragma unroll
                for (int bj = 0; bj < 2; ++bj) {
                    const int g32 = 8 * u.pn + 4 * bj + wc;
                    bf16_t* dst = Q + row * 1536 + ECOLP(bj);
                    const f32x4 x1 = acc[ai][bj][m][0] * rs, x2 = acc[ai][bj][m][1] * rs;
                    if (g32 % 3 == 2) {
                        const f32x4 c = ldg4(cosM + toff), s = ldg4(sinM + toff);
                        st_bf16x8(dst, x1 * c - x2 * s, x1 * s + x2 * c);
                    } else st_bf16x8(dst, x1, x2);
                }
            }
    }
};
struct EpiMlaKV {
    static constexpr bool PERM = true, AFTER_DRAIN = false;
    const u64* skv; bf16_t* KV;
    DI void operator()(const Acc& acc, const pg8::Unit& u, int wr, int wc, int fr, int fq) const {
        float rsv[2][4];
#pragma unroll
        for (int ai = 0; ai < 2; ++ai)
#pragma unroll
            for (int m = 0; m < 4; ++m) rsv[ai][m] = ld_dev(skv + EROW(ai, m));
#pragma unroll
        for (int ai = 0; ai < 2; ++ai)
#pragma unroll
            for (int m = 0; m < 4; ++m) {
                const size_t row = EROW(ai, m);
                const float rs = rsqrtf(rsv[ai][m] * (1.f / 256.f) + EPS);
#pragma unroll
                for (int bj = 0; bj < 2; ++bj) st_bf16x8(KV + row * 2048 + ECOLP(bj), acc[ai][bj][m][0] * rs, acc[ai][bj][m][1] * rs);
            }
    }
};
struct EpiFox {
    static constexpr bool PERM = true, AFTER_DRAIN = false;
    const u64* ssq; bf16_t* qkv; float* logf; const float* bf;
    DI void operator()(const Acc& acc, const pg8::Unit& u, int wr, int wc, int fr, int fq) const {
        float rsv[2][4];
#pragma unroll
        for (int ai = 0; ai < 2; ++ai)
#pragma unroll
            for (int m = 0; m < 4; ++m) rsv[ai][m] = ld_dev(ssq + EROW(ai, m));
#pragma unroll
        for (int ai = 0; ai < 2; ++ai)
#pragma unroll
            for (int m = 0; m < 4; ++m) {
                const size_t row = EROW(ai, m);
                const float rs = rsqrtf(rsv[ai][m] * (1.f / 1024.f) + EPS);
                if (u.pn < 12) {
                    const float sc = (u.pn < 4) ? rs * QS_64 : rs;
#pragma unroll
                    for (int bj = 0; bj < 2; ++bj) st_bf16x8(qkv + row * 3072 + ECOLP(bj), acc[ai][bj][m][0] * sc, acc[ai][bj][m][1] * sc);
                } else if (wc == 0 && fq < 2) {
#pragma unroll
                    for (int n = 0; n < 2; ++n) {
                        const f32x4 b = ldg4(bf + fq * 8 + 4 * n); const f32x4 x = acc[ai][0][m][n] * rs + b; f32x4 o;
#pragma unroll
                        for (int e = 0; e < 4; ++e) { const float xv = x[e]; o[e] = fminf(xv, 0.f) - __logf(1.f + __expf(-fabsf(xv))); }
                        stg4(logf + row * 16 + fq * 8 + 4 * n, o);
                    }
                }
            }
    }
};
struct EpiDil {
    static constexpr bool PERM = true, AFTER_DRAIN = false;
    const u64* ssq; bf16_t* qkv; const float* cosD; const float* sinD;
    DI void operator()(const Acc& acc, const pg8::Unit& u, int wr, int wc, int fr, int fq) const {
        const int sel = u.pn / 12;
        const int gg = (u.pn % 12) >> 2, ld = 2 * gg;
        float rsv[2][4];
#pragma unroll
        for (int ai = 0; ai < 2; ++ai)
#pragma unroll
            for (int m = 0; m < 4; ++m) rsv[ai][m] = ld_dev(ssq + EROW(ai, m));
#pragma unroll
        for (int ai = 0; ai < 2; ++ai)
#pragma unroll
            for (int m = 0; m < 4; ++m) {
                const size_t row = EROW(ai, m);
                const float rs0 = rsqrtf(rsv[ai][m] * (1.f / 1024.f) + EPS);
                const float rs = (sel == 0) ? rs0 * QS_64 : rs0;
                const int pos = (int)(row & (SEQ - 1));
                const int rho = ((pos & ((1 << ld) - 1)) << (12 - ld)) + (pos >> ld);
                f32x4 c = {0.f, 0.f, 0.f, 0.f}, s = c;
                if (sel < 2) { const int i0 = 16 * (wc & 1) + fq * 4; c = ldg4(cosD + pos * 32 + i0); s = ldg4(sinD + pos * 32 + i0); }
#pragma unroll
                for (int bj = 0; bj < 2; ++bj) {
                    f32x4 x1 = acc[ai][bj][m][0] * rs, x2 = acc[ai][bj][m][1] * rs;
                    if (sel < 2) { const f32x4 o1 = x1 * c - x2 * s, o2 = x1 * s + x2 * c; x1 = o1; x2 = o2; }
                    const int hd = ((u.pn & 3) << 2) + 2 * bj + (wc >> 1);
                    bf16_t* dst = qkv + ((size_t)((((int)(row >> 12) * 3 + sel) * 3 + gg) * 16 + hd) * 4096 + rho) * 64 + 32 * (wc & 1) + 8 * fq;
                    st_bf16x8(dst, x1, x2);
                }
            }
    }
};

DI void store_o_row(bf16_t* orow, const f32x16& o0, const f32x16& o1, float inv, int h) {
#pragma unroll
    for (int blk = 0; blk < 2; ++blk)
#pragma unroll
        for (int gp = 0; gp < 2; ++gp) {
            const f32x16& o = blk ? o1 : o0;
            const int ge = 8 * gp, go = 8 * gp + 4;
            const unsigned e0 = cvtpk(o[ge] * inv, o[ge + 1] * inv), e1 = cvtpk(o[ge + 2] * inv, o[ge + 3] * inv);
            const unsigned q0 = cvtpk(o[go] * inv, o[go + 1] * inv), q1 = cvtpk(o[go + 2] * inv, o[go + 3] * inv);
            const auto s0 = __builtin_amdgcn_permlane32_swap(e0, q0, false, false);
            const auto s1 = __builtin_amdgcn_permlane32_swap(e1, q1, false, false);
            u32x4 w; w.x = s0[0]; w.y = s1[0]; w.z = s0[1]; w.w = s1[1];
            *(GAS u32x4*)(orow + 32 * blk + 16 * gp + 8 * h) = w;
        }
}
typedef short v4i16_t __attribute__((ext_vector_type(4)));
DI bf16x8 vtr8(const LAS unsigned char* p, int row_pitch4) {
    const v4i16_t lo = __builtin_amdgcn_ds_read_tr16_b64_v4i16((LAS v4i16_t*)p), hi = __builtin_amdgcn_ds_read_tr16_b64_v4i16((LAS v4i16_t*)(p + row_pitch4));
    return (bf16x8){lo[0], lo[1], lo[2], lo[3], hi[0], hi[1], hi[2], hi[3]};
}
#define AT_VTR(p) vtr8((p), 4 * VP)
template <int DK, int MODE>
DI void attn_unit(LAS unsigned char* lds, const bf16_t* Qp, long qpitch, const bf16_t* Kp, long kpitch, const bf16_t* K2p, long k2pitch,
                  const bf16_t* Vp, long vpitch, bf16_t* Op, long opitch, const float* Dl, float* lsep, long lsepitch, int q0, int W,
                  bool pre, bool has_next, const bf16_t* Kn, const bf16_t* K2n, const bf16_t* Vn, const float* Dln,
                  u32x4& kreg0, u32x4& kreg1, u32x4& k2reg, u32x4& vreg0, u32x4& vreg1, f32x4& dkreg) {
    constexpr int KP = DK * 2 + 16, NS = DK / 16, VP = 192, VT_OFF = 128 * 208, DK_OFF = VT_OFF + 128 * VP, BUFSZ = 52224;
    static_assert(DK_OFF + 512 <= BUFSZ, "lds");
    constexpr float THR = 8.f;
    const int tid = otid(), lane = tid & 63, r = lane & 31, h = lane >> 5;
    const int wid = __builtin_amdgcn_readfirstlane(tid >> 6);
    const int wq0 = q0 + 32 * wid, q = wq0 + r;
    bf16x8 qf[NS];
    { const bf16_t* qrow = Qp + (long)q * qpitch;
#pragma unroll
      for (int s = 0; s < NS; ++s) qf[s] = *(const GAS bf16x8*)(qrow + 16 * s + 8 * h); }
    float dq = 0.f; if (MODE == 1) dq = *(const GAS float*)(Dl + q);
    f32x16 o0, o1;
#pragma unroll
    for (int i = 0; i < 16; ++i) { o0[i] = 0.f; o1[i] = 0.f; }
    float m_ref = 0.f, l_run = 0.f; bool first = true;
    const int t_lo = 0; (void)W;
    const int t_hi = (q0 + 255) >> 7;
    const int lkey = tid >> 3, lch = tid & 7;
#define AT_ISSUE(t) do { const long kb_ = 128L * (t); \
        kreg0 = *(const GAS u32x4*)(Kp + (kb_ + lkey) * kpitch + lch * 8); kreg1 = *(const GAS u32x4*)(Kp + (kb_ + lkey + 64) * kpitch + lch * 8); \
        if (MODE == 0) k2reg = *(const GAS u32x4*)(K2p + (kb_ + (tid >> 2)) * k2pitch + (tid & 3) * 8); \
        vreg0 = *(const GAS u32x4*)(Vp + (kb_ + lkey) * vpitch + lch * 8); vreg1 = *(const GAS u32x4*)(Vp + (kb_ + lkey + 64) * vpitch + lch * 8); \
        if (MODE == 1 && tid < 32) dkreg = *(const GAS f32x4*)(Dl + kb_ + 4 * tid); } while (0)
#define AT_WRITE(bufp) do { LAS unsigned char* b_ = (bufp); \
        *(LAS u32x4*)(b_ + lkey * KP + lch * 16) = kreg0; *(LAS u32x4*)(b_ + (lkey + 64) * KP + lch * 16) = kreg1; \
        if (MODE == 0) *(LAS u32x4*)(b_ + (tid >> 2) * KP + 128 + (tid & 3) * 16) = k2reg; \
        *(LAS u32x4*)(b_ + VT_OFF + lkey * VP + lch * 16) = vreg0; *(LAS u32x4*)(b_ + VT_OFF + (lkey + 64) * VP + lch * 16) = vreg1; \
        if (MODE == 1 && tid < 32) *(LAS f32x4*)(b_ + DK_OFF + 16 * tid) = dkreg; } while (0)
#define AT_ISSUE_NEXT() do { \
        kreg0 = *(const GAS u32x4*)(Kn + (long)lkey * kpitch + lch * 8); kreg1 = *(const GAS u32x4*)(Kn + (long)(lkey + 64) * kpitch + lch * 8); \
        if (MODE == 0) k2reg = *(const GAS u32x4*)(K2n + (long)(tid >> 2) * k2pitch + (tid & 3) * 8); \
        vreg0 = *(const GAS u32x4*)(Vn + (long)lkey * vpitch + lch * 8); vreg1 = *(const GAS u32x4*)(Vn + (long)(lkey + 64) * vpitch + lch * 8); \
        if (MODE == 1 && tid < 32) dkreg = *(const GAS f32x4*)(Dln + 4 * tid); } while (0)
    if (!pre) AT_ISSUE(t_lo);
    AT_WRITE(lds + (t_lo & 1) * BUFSZ);
    if (t_lo < t_hi) AT_ISSUE(t_lo + 1);
    __syncthreads();
    const int pr = (r & 19) | ((r & 4) << 1) | ((r & 8) >> 1);
    const int vtr_base = (8 * h + ((lane & 15) >> 2)) * VP + (16 * ((lane >> 4) & 1) + 4 * (lane & 3)) * 2;
#define AT_S(P0, P1, SUB) do { \
        const LAS unsigned char* ka_ = buf + (64 * (SUB) + pr) * KP + h * 16; constexpr int NH = NS / 2; bf16x8 kf[2 * NH]; \
        _Pragma("unroll") for (int s = 0; s < NH; ++s) { kf[2 * s] = *(const LAS bf16x8*)(ka_ + s * 32); kf[2 * s + 1] = *(const LAS bf16x8*)(ka_ + 32 * KP + s * 32); } \
        f32x16 i0_, i1_; \
        if (MODE == 1) { const float base = dq - m_ref; const LAS unsigned char* dk_ = buf + DK_OFF + 256 * (SUB); \
            _Pragma("unroll") for (int a = 0; a < 2; ++a) { \
                const f32x4 d0 = *(const LAS f32x4*)(dk_ + 4 * (16 * a + 8 * h)), d1 = *(const LAS f32x4*)(dk_ + 4 * (16 * a + 8 * h + 4)); \
                const f32x4 e0 = *(const LAS f32x4*)(dk_ + 4 * (32 + 16 * a + 8 * h)), e1 = *(const LAS f32x4*)(dk_ + 4 * (32 + 16 * a + 8 * h + 4)); \
                _Pragma("unroll") for (int e = 0; e < 4; ++e) { i0_[8 * a + e] = base - d0[e]; i0_[8 * a + 4 + e] = base - d1[e]; i1_[8 * a + e] = base - e0[e]; i1_[8 * a + 4 + e] = base - e1[e]; } } } \
        else { _Pragma("unroll") for (int i = 0; i < 16; ++i) { i0_[i] = -m_ref; i1_[i] = -m_ref; } } \
        \
        P0 = __builtin_amdgcn_mfma_f32_32x32x16_bf16(kf[0], qf[0], i0_, 0, 0, 0); P1 = __builtin_amdgcn_mfma_f32_32x32x16_bf16(kf[1], qf[0], i1_, 0, 0, 0); \
        _Pragma("unroll") for (int s = 1; s < NH; ++s) { \
            P0 = __builtin_amdgcn_mfma_f32_32x32x16_bf16(kf[2 * s], qf[s], P0, 0, 0, 0); P1 = __builtin_amdgcn_mfma_f32_32x32x16_bf16(kf[2 * s + 1], qf[s], P1, 0, 0, 0); } \
        _Pragma("unroll") for (int s = 0; s < NH; ++s) { kf[2 * s] = *(const LAS bf16x8*)(ka_ + (NH + s) * 32); kf[2 * s + 1] = *(const LAS bf16x8*)(ka_ + 32 * KP + (NH + s) * 32); } \
        \
        _Pragma("unroll") for (int s = 0; s < NH; ++s) { \
            P0 = __builtin_amdgcn_mfma_f32_32x32x16_bf16(kf[2 * s], qf[NH + s], P0, 0, 0, 0); P1 = __builtin_amdgcn_mfma_f32_32x32x16_bf16(kf[2 * s + 1], qf[NH + s], P1, 0, 0, 0); } \
        } while (0)
#define AT_SM(P0, P1, SUB, ADJ, OTH0, OTH1) do { \
        const int kb_ = 128 * t + 64 * (SUB); \
        const LAS unsigned char* va_ = buf + VT_OFF + vtr_base + 64 * (SUB) * VP; bf16x8 vf[4]; \
        _Pragma("unroll") for (int s = 0; s < 2; ++s) { vf[2 * s] = AT_VTR(va_ + 16 * s * VP); vf[2 * s + 1] = AT_VTR(va_ + 16 * s * VP + 64); } \
        if (kb_ + 63 > wq0) {     \
            _Pragma("unroll") for (int i = 0; i < 16; ++i) { const int kk = kb_ + (i & 7) + 8 * h + 16 * (i >> 3); \
                if (kk > q) P0[i] = -1e30f; if (kk + 32 > q) P1[i] = -1e30f; } } \
        float mxa = fmaxf(fmaxf(P0[0], P1[0]), P0[1]), mxb = fmaxf(fmaxf(P0[4], P1[4]), P0[5]), mxc = fmaxf(fmaxf(P0[8], P1[8]), P0[9]), mxd = fmaxf(fmaxf(P0[12], P1[12]), P0[13]); \
        mxa = fmaxf(fmaxf(mxa, P1[1]), P0[2]); mxb = fmaxf(fmaxf(mxb, P1[5]), P0[6]); mxc = fmaxf(fmaxf(mxc, P1[9]), P0[10]); mxd = fmaxf(fmaxf(mxd, P1[13]), P0[14]); \
        mxa = fmaxf(fmaxf(mxa, P1[2]), P0[3]); mxb = fmaxf(fmaxf(mxb, P1[6]), P0[7]); mxc = fmaxf(fmaxf(mxc, P1[10]), P0[11]); mxd = fmaxf(fmaxf(mxd, P1[14]), P0[15]); \
        mxa = fmaxf(fmaxf(mxa, P1[3]), mxb); mxc = fmaxf(fmaxf(mxc, P1[7]), mxd); float mx = fmaxf(fmaxf(mxa, P1[11]), fmaxf(mxc, P1[15])); \
        { const auto rr_ = __builtin_amdgcn_permlane32_swap(__float_as_uint(mx), __float_as_uint(mx), false, false); mx = fmaxf(__uint_as_float(rr_[0]), __uint_as_float(rr_[1])); } \
        if (first || __any(mx > THR)) { \
            const float dl = first ? mx : fmaxf(mx, 0.f); m_ref += dl; \
            if (!first) { const float alpha = __builtin_amdgcn_exp2f(-dl); l_run *= alpha; o0 *= alpha; o1 *= alpha; } \
            _Pragma("unroll") for (int i = 0; i < 16; ++i) { P0[i] -= dl; P1[i] -= dl; } \
            if (ADJ) { _Pragma("unroll") for (int i = 0; i < 16; ++i) { OTH0[i] -= dl; OTH1[i] -= dl; } } \
            first = false; } \
        float ls0 = 0.f, ls1 = 0.f, ls2 = 0.f, ls3 = 0.f; \
        _Pragma("unroll") for (int i = 0; i < 16; i += 4) { \
            P0[i] = __builtin_amdgcn_exp2f(P0[i]); P1[i] = __builtin_amdgcn_exp2f(P1[i]); P0[i + 1] = __builtin_amdgcn_exp2f(P0[i + 1]); P1[i + 1] = __builtin_amdgcn_exp2f(P1[i + 1]); \
            P0[i + 2] = __builtin_amdgcn_exp2f(P0[i + 2]); P1[i + 2] = __builtin_amdgcn_exp2f(P1[i + 2]); P0[i + 3] = __builtin_amdgcn_exp2f(P0[i + 3]); P1[i + 3] = __builtin_amdgcn_exp2f(P1[i + 3]); \
            ls0 += P0[i] + P1[i]; ls1 += P0[i + 1] + P1[i + 1]; ls2 += P0[i + 2] + P1[i + 2]; ls3 += P0[i + 3] + P1[i + 3]; } \
        l_run += (ls0 + ls1) + (ls2 + ls3); \
        u32x4 w0, w1, w2, w3; \
        w0.x = cvtpk(P0[0], P0[1]); w0.y = cvtpk(P0[2], P0[3]); w0.z = cvtpk(P0[4], P0[5]); w0.w = cvtpk(P0[6], P0[7]); \
        w1.x = cvtpk(P0[8], P0[9]); w1.y = cvtpk(P0[10], P0[11]); w1.z = cvtpk(P0[12], P0[13]); w1.w = cvtpk(P0[14], P0[15]); \
        w2.x = cvtpk(P1[0], P1[1]); w2.y = cvtpk(P1[2], P1[3]); w2.z = cvtpk(P1[4], P1[5]); w2.w = cvtpk(P1[6], P1[7]); \
        w3.x = cvtpk(P1[8], P1[9]); w3.y = cvtpk(P1[10], P1[11]); w3.z = cvtpk(P1[12], P1[13]); w3.w = cvtpk(P1[14], P1[15]); \
        const bf16x8 pf0 = __builtin_bit_cast(bf16x8, w0), pf1 = __builtin_bit_cast(bf16x8, w1), pf2 = __builtin_bit_cast(bf16x8, w2), pf3 = __builtin_bit_cast(bf16x8, w3); \
        \
        o0 = __builtin_amdgcn_mfma_f32_32x32x16_bf16(vf[0], pf0, o0, 0, 0, 0); o1 = __builtin_amdgcn_mfma_f32_32x32x16_bf16(vf[1], pf0, o1, 0, 0, 0); \
        o0 = __builtin_amdgcn_mfma_f32_32x32x16_bf16(vf[2], pf1, o0, 0, 0, 0); o1 = __builtin_amdgcn_mfma_f32_32x32x16_bf16(vf[3], pf1, o1, 0, 0, 0); \
        _Pragma("unroll") for (int s = 0; s < 2; ++s) { vf[2 * s] = AT_VTR(va_ + 16 * (s + 2) * VP); vf[2 * s + 1] = AT_VTR(va_ + 16 * (s + 2) * VP + 64); } \
        \
        o0 = __builtin_amdgcn_mfma_f32_32x32x16_bf16(vf[0], pf2, o0, 0, 0, 0); o1 = __builtin_amdgcn_mfma_f32_32x32x16_bf16(vf[1], pf2, o1, 0, 0, 0); \
        o0 = __builtin_amdgcn_mfma_f32_32x32x16_bf16(vf[2], pf3, o0, 0, 0, 0); o1 = __builtin_amdgcn_mfma_f32_32x32x16_bf16(vf[3], pf3, o1, 0, 0, 0); \
        } while (0)
    for (int t = t_lo; t <= t_hi; ++t) {
        if (t < t_hi) { AT_WRITE(lds + ((t + 1) & 1) * BUFSZ); if (t + 1 < t_hi) AT_ISSUE(t + 2); }
        if (t == t_hi && has_next) AT_ISSUE_NEXT();
        const LAS unsigned char* buf = lds + (t & 1) * BUFSZ;
        const int kbA = 128 * t, kbB = kbA + 64;
        const bool actA = (kbA <= wq0 + 31);
        const bool actB = (kbB <= wq0 + 31);
        f32x16 pA0, pA1, pB0, pB1;
        if (actA && actB) {
            AT_S(pA0, pA1, 0); AT_S(pB0, pB1, 1);
            AT_SM(pA0, pA1, 0, true, pB0, pB1);
            AT_SM(pB0, pB1, 1, false, pA0, pA1);
        } else if (actA) {
            AT_S(pA0, pA1, 0); AT_SM(pA0, pA1, 0, false, pB0, pB1);
        } else if (actB) {
            AT_S(pB0, pB1, 1); AT_SM(pB0, pB1, 1, false, pA0, pA1);
        }
        __syncthreads();
    }
#undef AT_ISSUE
#undef AT_ISSUE_NEXT
#undef AT_WRITE
#undef AT_S
#undef AT_SM
    const float l_tot = l_run + __shfl_xor(l_run, 32);
    const float inv = 1.f / l_tot;
    bf16_t* orow = Op + (long)q * opitch;
    store_o_row(orow, o0, o1, inv, h);
    if (MODE == 2 && h == 0) *(GAS float*)(lsep + (long)q * lsepitch) = m_ref + __log2f(l_tot);
}

DI void dil_decode(int L, const bf16_t* QKVC, size_t& qoff, size_t& koff, size_t& voff, size_t& lseoff, int& lsepitch, int& q0) {
    const int j = L & 15, g3 = (L >> 4) % 3, rest = (L >> 4) / 3, hd = rest & 15, bl = rest >> 4;
    const int d = (g3 == 0) ? 1 : (g3 == 1) ? 4 : 16;
    const int res = (g3 == 0) ? 0 : (g3 == 1) ? (j >> 2) : j;
    const int qb = (g3 == 0) ? j : (g3 == 1) ? (j & 3) : 0;
    const size_t prow = (size_t)res * (SEQ / d);
    qoff = ((size_t)(((bl * 3 + 0) * 3 + g3) * 16 + hd) * 4096 + prow) * 64;
    koff = ((size_t)(((bl * 3 + 1) * 3 + g3) * 16 + hd) * 4096 + prow) * 64;
    voff = ((size_t)(((bl * 3 + 2) * 3 + g3) * 16 + hd) * 4096 + prow) * 64;
    lseoff = ((size_t)bl * SEQ + res) * 48 + g3 * 16 + hd; lsepitch = d * 48; q0 = qb * 256;
}
DI void dil_phase(LAS unsigned char* lds, bf16_t* QKVC, float* LSE, int bx, int G) {
    constexpr int KP = 144, VP = 192, VT_OFF = 384 * KP, W = 128;
    constexpr float THR = 8.f;
    const int tid = otid(), lane = tid & 63, r = lane & 31, h = lane >> 5;
    const int wid = __builtin_amdgcn_readfirstlane(tid >> 6);
    const int lkey = tid >> 3, lch = tid & 7;
    const int pr = (r & 19) | ((r & 4) << 1) | ((r & 8) >> 1);
    const int vtr_base = (8 * h + ((lane & 15) >> 2)) * VP + (16 * ((lane >> 4) & 1) + 4 * (lane & 3)) * 2;
    u32x4 kreg[6], vreg[6]; bf16x8 qn[4];
    int L = bx; if (L >= 3072) return;
    size_t qoff, koff, voff, lseoff; int lsepitch, q0;
    dil_decode(L, QKVC, qoff, koff, voff, lseoff, lsepitch, q0);
#define DL_ISSUE(QO, KO, VO, Q0) do { const int kbase_ = ((Q0) == 0) ? 0 : (Q0) - 128; \
        _Pragma("unroll") for (int j = 0; j < 6; ++j) if (j < 4 || (Q0) != 0) { \
            kreg[j] = *(const GAS u32x4*)(QKVC + (KO) + (size_t)(kbase_ + lkey + 64 * j) * 64 + lch * 8); \
            vreg[j] = *(const GAS u32x4*)(QKVC + (VO) + (size_t)(kbase_ + lkey + 64 * j) * 64 + lch * 8); } \
        _Pragma("unroll") for (int s = 0; s < 4; ++s) qn[s] = *(const GAS bf16x8*)(QKVC + (QO) + (size_t)((Q0) + 32 * wid + r) * 64 + 16 * s + 8 * h); } while (0)
    DL_ISSUE(qoff, koff, voff, q0);
    for (;;) {
        const int nj = (q0 == 0) ? 4 : 6, kbase = (q0 == 0) ? 0 : q0 - 128;
#pragma unroll
        for (int j = 0; j < 6; ++j) if (j < nj) {
            *(LAS u32x4*)(lds + (lkey + 64 * j) * KP + lch * 16) = kreg[j];
            *(LAS u32x4*)(lds + VT_OFF + (lkey + 64 * j) * VP + lch * 16) = vreg[j];
        }
        bf16x8 qf[4];
#pragma unroll
        for (int s = 0; s < 4; ++s) qf[s] = qn[s];
        __syncthreads();
        const int Ln = L + G; const bool has_next = Ln < 3072;
        size_t nqoff = 0, nkoff = 0, nvoff = 0, nlseoff = 0; int nlsepitch = 0, nq0 = 0;
        if (has_next) { dil_decode(Ln, QKVC, nqoff, nkoff, nvoff, nlseoff, nlsepitch, nq0); DL_ISSUE(nqoff, nkoff, nvoff, nq0); }
        const int wq0 = q0 + 32 * wid, q = wq0 + r;
        f32x16 o0, o1;
#pragma unroll
        for (int i = 0; i < 16; ++i) { o0[i] = 0.f; o1[i] = 0.f; }
        float m_ref = 0.f, l_run = 0.f; bool first = true;
        int u_lo = (wq0 - W - kbase) >> 6; if (u_lo < 0) u_lo = 0;
        int u_hi = (wq0 + 31 - kbase) >> 6; if (u_hi > nj - 1) u_hi = nj - 1;
        for (int u = u_lo; u <= u_hi; ++u) {
            const int kb = kbase + 64 * u;
            const LAS unsigned char* ka = lds + (64 * u + pr) * KP + h * 16;
            bf16x8 kf[8];
#pragma unroll
            for (int s = 0; s < 4; ++s) { kf[2 * s] = *(const LAS bf16x8*)(ka + s * 32); kf[2 * s + 1] = *(const LAS bf16x8*)(ka + 32 * KP + s * 32); }
            f32x16 p0, p1;
#pragma unroll
            for (int i = 0; i < 16; ++i) { p0[i] = -m_ref; p1[i] = -m_ref; }
#pragma unroll
            for (int s = 0; s < 4; ++s) {
                p0 = __builtin_amdgcn_mfma_f32_32x32x16_bf16(kf[2 * s], qf[s], p0, 0, 0, 0);
                p1 = __builtin_amdgcn_mfma_f32_32x32x16_bf16(kf[2 * s + 1], qf[s], p1, 0, 0, 0);
            }
            const LAS unsigned char* va = lds + VT_OFF + vtr_base + 64 * u * VP; bf16x8 vf[8];
#pragma unroll
            for (int s = 0; s < 4; ++s) { vf[2 * s] = vtr8(va + 16 * s * VP, 4 * VP); vf[2 * s + 1] = vtr8(va + 16 * s * VP + 64, 4 * VP); }
            if ((kb + 63 > wq0) || (kb < wq0 + 31 - W)) {
#pragma unroll
                for (int i = 0; i < 16; ++i) { const int kk = kb + (i & 7) + 8 * h + 16 * (i >> 3);
                    if (kk > q || kk < q - W) p0[i] = -1e30f; if (kk + 32 > q || kk + 32 < q - W) p1[i] = -1e30f; }
            }
            float mxa = fmaxf(fmaxf(p0[0], p1[0]), p0[1]), mxb = fmaxf(fmaxf(p0[4], p1[4]), p0[5]), mxc = fmaxf(fmaxf(p0[8], p1[8]), p0[9]), mxd = fmaxf(fmaxf(p0[12], p1[12]), p0[13]);
            mxa = fmaxf(fmaxf(mxa, p1[1]), p0[2]); mxb = fmaxf(fmaxf(mxb, p1[5]), p0[6]); mxc = fmaxf(fmaxf(mxc, p1[9]), p0[10]); mxd = fmaxf(fmaxf(mxd, p1[13]), p0[14]);
            mxa = fmaxf(fmaxf(mxa, p1[2]), p0[3]); mxb = fmaxf(fmaxf(mxb, p1[6]), p0[7]); mxc = fmaxf(fmaxf(mxc, p1[10]), p0[11]); mxd = fmaxf(fmaxf(mxd, p1[14]), p0[15]);
            mxa = fmaxf(fmaxf(mxa, p1[3]), mxb); mxc = fmaxf(fmaxf(mxc, p1[7]), mxd); float mx = fmaxf(fmaxf(mxa, p1[11]), fmaxf(mxc, p1[15]));
            { const auto rr_ = __builtin_amdgcn_permlane32_swap(__float_as_uint(mx), __float_as_uint(mx), false, false); mx = fmaxf(__uint_as_float(rr_[0]), __uint_as_float(rr_[1])); }
            if (first || __any(mx > THR)) {
                const float dl = first ? mx : fmaxf(mx, 0.f); m_ref += dl;
                if (!first) { const float alpha = __builtin_amdgcn_exp2f(-dl); l_run *= alpha; o0 *= alpha; o1 *= alpha; }
#pragma unroll
                for (int i = 0; i < 16; ++i) { p0[i] -= dl; p1[i] -= dl; }
                first = false;
            }
            float ls0 = 0.f, ls1 = 0.f, ls2 = 0.f, ls3 = 0.f;
#pragma unroll
            for (int i = 0; i < 16; i += 4) {
                p0[i] = __builtin_amdgcn_exp2f(p0[i]); p1[i] = __builtin_amdgcn_exp2f(p1[i]); p0[i + 1] = __builtin_amdgcn_exp2f(p0[i + 1]); p1[i + 1] = __builtin_amdgcn_exp2f(p1[i + 1]);
                p0[i + 2] = __builtin_amdgcn_exp2f(p0[i + 2]); p1[i + 2] = __builtin_amdgcn_exp2f(p1[i + 2]); p0[i + 3] = __builtin_amdgcn_exp2f(p0[i + 3]); p1[i + 3] = __builtin_amdgcn_exp2f(p1[i + 3]);
                ls0 += p0[i] + p1[i]; ls1 += p0[i + 1] + p1[i + 1]; ls2 += p0[i + 2] + p1[i + 2]; ls3 += p0[i + 3] + p1[i + 3]; }
            l_run += (ls0 + ls1) + (ls2 + ls3);
            u32x4 w0, w1, w2, w3;
            w0.x = cvtpk(p0[0], p0[1]); w0.y = cvtpk(p0[2], p0[3]); w0.z = cvtpk(p0[4], p0[5]); w0.w = cvtpk(p0[6], p0[7]);
            w1.x = cvtpk(p0[8], p0[9]); w1.y = cvtpk(p0[10], p0[11]); w1.z = cvtpk(p0[12], p0[13]); w1.w = cvtpk(p0[14], p0[15]);
            w2.x = cvtpk(p1[0], p1[1]); w2.y = cvtpk(p1[2], p1[3]); w2.z = cvtpk(p1[4], p1[5]); w2.w = cvtpk(p1[6], p1[7]);
            w3.x = cvtpk(p1[8], p1[9]); w3.y = cvtpk(p1[10], p1[11]); w3.z = cvtpk(p1[12], p1[13]); w3.w = cvtpk(p1[14], p1[15]);
            const bf16x8 pf0 = __builtin_bit_cast(bf16x8, w0), pf1 = __builtin_bit_cast(bf16x8, w1), pf2 = __builtin_bit_cast(bf16x8, w2), pf3 = __builtin_bit_cast(bf16x8, w3);
            o0 = __builtin_amdgcn_mfma_f32_32x32x16_bf16(vf[0], pf0, o0, 0, 0, 0); o1 = __builtin_amdgcn_mfma_f32_32x32x16_bf16(vf[1], pf0, o1, 0, 0, 0);
            o0 = __builtin_amdgcn_mfma_f32_32x32x16_bf16(vf[2], pf1, o0, 0, 0, 0); o1 = __builtin_amdgcn_mfma_f32_32x32x16_bf16(vf[3], pf1, o1, 0, 0, 0);
            o0 = __builtin_amdgcn_mfma_f32_32x32x16_bf16(vf[4], pf2, o0, 0, 0, 0); o1 = __builtin_amdgcn_mfma_f32_32x32x16_bf16(vf[5], pf2, o1, 0, 0, 0);
            o0 = __builtin_amdgcn_mfma_f32_32x32x16_bf16(vf[6], pf3, o0, 0, 0, 0); o1 = __builtin_amdgcn_mfma_f32_32x32x16_bf16(vf[7], pf3, o1, 0, 0, 0);
        }
        const float l_tot = l_run + __shfl_xor(l_run, 32);
        const float inv = 1.f / l_tot;
        bf16_t* orow = QKVC + qoff + (size_t)q * 64;
        store_o_row(orow, o0, o1, inv, h);
        if (h == 0) *(GAS float*)(LSE + lseoff + (size_t)q * lsepitch) = m_ref + __log2f(l_tot);
        __syncthreads();
        if (!has_next) break;
        L = Ln; qoff = nqoff; koff = nkoff; voff = nvoff; lseoff = nlseoff; lsepitch = nlsepitch; q0 = nq0;
    }
#undef DL_ISSUE
}

DI void sincos_acc(float ang, float& s, float& c) {
    const double x = (double)ang;
    const double k = __builtin_rint(x * 0.63661977236758134);
    double rr = __builtin_fma(-k, 1.5707963267948966, x); rr = __builtin_fma(-k, 6.123233995736766e-17, rr);
    const int qd = ((int)k) & 3;
    const double r2 = rr * rr;
    const double sp = rr * (1.0 + r2 * (-1.0 / 6 + r2 * (1.0 / 120 + r2 * (-1.0 / 5040 + r2 * (1.0 / 362880 + r2 * (-1.0 / 39916800 + r2 * (1.0 / 6227020800.0)))))));
    const double cp = 1.0 + r2 * (-0.5 + r2 * (1.0 / 24 + r2 * (-1.0 / 720 + r2 * (1.0 / 40320 + r2 * (-1.0 / 3628800 + r2 * (1.0 / 479001600 + r2 * (-1.0 / 87178291200.0)))))));
    const double sv = (qd == 0) ? sp : (qd == 1) ? cp : (qd == 2) ? -sp : -cp;
    const double cv = (qd == 0) ? cp : (qd == 1) ? -sp : (qd == 2) ? -cp : sp;
    s = (float)sv; c = (float)cv;
}
DI int perm_dil(int l) { return (l & ~63) | (((l >> 4) & 1) << 5) | (((l >> 2) & 3) << 3) | (((l >> 5) & 1) << 2) | (l & 3); }
DI int perm_r32(int l) { return (l & ~31) | (((l >> 2) & 3) << 3) | (((l >> 4) & 1) << 2) | (l & 3); }
DI void cvt_item(const float* W, int ldw, int col0, int ncols, int K, const float* gain, bf16_t* WT, int row_off, int mode, LAS float* scr, int item, int lane) {
    const int nblk = (ncols + 31) >> 5, kb = item / nblk, nb = item - kb * nblk, k0 = 64 * kb, n0 = 32 * nb;
    const int nn = n0 + (lane & 31); const bool ok = nn < ncols;
#pragma unroll
    for (int i = 0; i < 32; ++i) { const int kk = 2 * i + (lane >> 5); float w = ok ? *(const GAS float*)(W + (size_t)(k0 + kk) * ldw + col0 + nn) : 0.f; if (gain) w *= *(const GAS float*)(gain + k0 + kk); scr[kk * 33 + (lane & 31)] = w; }
    asm volatile("s_waitcnt lgkmcnt(0)" ::: "memory");
    const int c = lane & 7;
#pragma unroll
    for (int j = 0; j < 4; ++j) { const int n = (lane >> 3) + 8 * j, nsrc = n0 + n; const LAS float* s = scr + (8 * c) * 33 + n;
        if (nsrc < ncols) { const int ndst = (mode == 1 && nsrc < 6144) ? perm_dil(nsrc) : (mode == 2 && ((nsrc >> 5) % 3) == 2) ? perm_r32(nsrc) : (mode == 3) ? perm_r32(nsrc) : nsrc;
            u32x4 o; o.x = cvtpk(s[0 * 33], s[1 * 33]); o.y = cvtpk(s[2 * 33], s[3 * 33]); o.z = cvtpk(s[4 * 33], s[5 * 33]); o.w = cvtpk(s[6 * 33], s[7 * 33]);
            *(GAS u32x4*)(WT + (size_t)(row_off + ndst) * K + k0 + 8 * c) = o; } }
    asm volatile("s_waitcnt lgkmcnt(0)" ::: "memory");
}
DI void cvt_job(const float* W, int ldw, int col0, int ncols, int K, const float* gain, bf16_t* WT, int row_off, int mode, LAS float* scr, int gw, int NGW, int lane) {
    const int items = (K >> 6) * ((ncols + 31) >> 5);
    for (int it = gw; it < items; it += NGW) cvt_item(W, ldw, col0, ncols, K, gain, WT, row_off, mode, scr, it, lane);
}
DI void zero_rows(bf16_t* p, size_t nelem, int gt, int NGT) {
    const u32x4 z = {0, 0, 0, 0};
    for (size_t i = (size_t)gt * 8; i < nelem; i += (size_t)NGT * 8) *(GAS u32x4*)(p + i) = z;
}

#define XB_TMO      128
#define XB_XCNT(j)  (256  + 64 * (j))
#define XB_XSUB(j)  (1280 + 64 * (j))
#define XB_XGEN(j)  (2304 + 64 * (j))
#define XB_TOP      3328
#define XB_TOPGEN   3392
#define XCD_BAR_WORDS 3456
#define XB_SPIN_CAP (1u << 18)

__device__ __forceinline__ unsigned xb_ld(unsigned* p)              { return __hip_atomic_load(p, __ATOMIC_RELAXED, __HIP_MEMORY_SCOPE_AGENT); }
__device__ __forceinline__ unsigned xb_add(unsigned* p, unsigned v) { return __hip_atomic_fetch_add(p, v, __ATOMIC_RELAXED, __HIP_MEMORY_SCOPE_AGENT); }
__device__ __forceinline__ unsigned xb_xcc_id() { return (unsigned)__builtin_amdgcn_s_getreg((3 << 11) | 20) & 0xFu; }
#define XB_SPIN(cond, bar) do { unsigned _sp = 0; while (cond) { __builtin_amdgcn_s_sleep(1); \
    if ((++_sp & 255u) == 0u) { if (xb_ld(&(bar)[XB_TMO])) break; if (_sp > XB_SPIN_CAP) { atomicAdd(&(bar)[XB_TMO], 1u); break; } } } } while (0)

struct XcdBarrier {
    unsigned* bar; unsigned x;
    volatile LAS unsigned* st;
};

__device__ __forceinline__ XcdBarrier xcd_barrier_post(unsigned* bar, volatile LAS unsigned* st) {
    XcdBarrier b; b.bar = bar; b.x = xb_xcc_id(); b.st = st;
    if (threadIdx.x == 0) (void)xb_add(&bar[XB_XCNT(b.x)], 1u);
    return b;
}
__device__ __forceinline__ void xcd_barrier_complete(unsigned* bar, unsigned x, unsigned& nloc, unsigned& nx) {
    const unsigned G = gridDim.x * gridDim.y * gridDim.z;
    unsigned sum, cnt, mine, sp = 0u;
    for (;;) {
        sum = 0u; cnt = 0u; mine = 0u;
#pragma unroll
        for (unsigned j = 0; j < 16; ++j) { const unsigned c = xb_ld(&bar[XB_XCNT(j)]); sum += c; cnt += (c > 0u) ? 1u : 0u; mine = (j == x) ? c : mine; }
        if (sum == G) break;
        __builtin_amdgcn_s_sleep(1);
        if ((++sp & 255u) == 0u) { if (xb_ld(&bar[XB_TMO])) break; if (sp > XB_SPIN_CAP) { atomicAdd(&bar[XB_TMO], 1u); break; } }
    }
    nloc = mine > 0u ? mine : 1u; nx = cnt > 0u ? cnt : 1u;
}

__device__ __forceinline__ void xcd_barrier(const XcdBarrier& b) {
    asm volatile("s_waitcnt vmcnt(0)" ::: "memory");
    __syncthreads();
    if (threadIdx.x == 0) {
        unsigned* bar = b.bar;
        __builtin_amdgcn_s_waitcnt(0);
        unsigned nloc = b.st[0], nx = b.st[1];
        if (nloc == 0u) { xcd_barrier_complete(bar, b.x, nloc, nx); b.st[0] = nloc; b.st[1] = nx; }
        const unsigned old = xb_add(&bar[XB_XSUB(b.x)], 1u);
        const unsigned gen = old / nloc;
        if (old + 1u == (gen + 1u) * nloc) {
            __builtin_amdgcn_fence(__ATOMIC_RELEASE, "agent");
            asm volatile("s_waitcnt vmcnt(0)" ::: "memory");
            const unsigned og = xb_add(&bar[XB_TOP], 1u);
            const unsigned tg = og / nx;
            if (og + 1u == (tg + 1u) * nx) xb_add(&bar[XB_TOPGEN], 1u);
            else XB_SPIN(xb_ld(&bar[XB_TOPGEN]) == tg, bar);
            __builtin_amdgcn_fence(__ATOMIC_ACQUIRE, "agent");
            xb_add(&bar[XB_XGEN(b.x)], 1u);
            asm volatile("s_waitcnt vmcnt(0)" ::: "memory");
        } else {
            XB_SPIN(xb_ld(&bar[XB_XGEN(b.x)]) == gen, bar);
            __builtin_amdgcn_fence(__ATOMIC_ACQUIRE, "agent");
            asm volatile("s_waitcnt vmcnt(0)" ::: "memory");
        }
    }
    __syncthreads();
}

DI const float* ldarg(int idx) {
    const float* p; const int off = __builtin_amdgcn_readfirstlane(idx * 8);
    asm volatile("s_load_dwordx2 %0, %1, %2\n\ts_waitcnt lgkmcnt(0)" : "=s"(p) : "s"(__builtin_amdgcn_kernarg_segment_ptr()), "s"(off) : "memory");
    return p;
}
DI void cvt_layer(int layer, bf16_t* WB, u64* SQ, u64* SKV, LAS float* scr, int gw, int NGW, int gt, int NGT, int lane) {
    const int kind = (layer == 3) ? 0 : layer;
    const int b0 = layer == 0 ? 1 : layer == 1 ? 12 : layer == 2 ? 20 : 26;
    for (int i = gt; i < T_TOK; i += NGT) { st_dev(SQ + i, 0.f); st_dev(SKV + i, 0.f); }
    const float* attn_norm = ldarg(b0);
    const int bw = b0 + (kind == 0 ? 7 : kind == 1 ? 4 : 2);
    const float* w_o = ldarg(bw); const float* mlp_norm = ldarg(bw + 1); const float* w_up = ldarg(bw + 2); const float* w_down = ldarg(bw + 3);
#define CJ(W_, ldw_, col0_, ncols_, K_, gain_, WT_, roff_, mode_) { const int n_ = ((K_) >> 6) * (((ncols_) + 31) >> 5); \
        if (r_ < n_) { cvt_item(W_, ldw_, col0_, ncols_, K_, gain_, WT_, roff_, mode_, scr, r_, lane); continue; } r_ -= n_; }
#define CJ_MLP CJ(w_up, 4096, 0, 4096, 1024, mlp_norm, WB + WO_UP, 0, 0) CJ(w_down, 1024, 0, 1024, 4096, nullptr, WB + WO_DOWN, 0, 0) CJ(w_o, 1024, 0, 1024, 1024, nullptr, WB + WO_WO, 0, 0)
    if (kind == 0) {
        const float* wq_a = ldarg(b0 + 1); const float* wkv_a = ldarg(b0 + 4);
        const float* q_norm = ldarg(b0 + 2); const float* wq_b = ldarg(b0 + 3); const float* kv_norm = ldarg(b0 + 5); const float* wkv_b = ldarg(b0 + 6);
        zero_rows(WB + WO_MIX + (size_t)672 * 1024, (size_t)96 * 1024, gt, NGT);
        for (int it = gw; it < 2048 + 2048 + 512 + 128 + 192 + 16 + 288 + 256; it += NGW) { int r_ = it;
            CJ_MLP
            CJ(wkv_a, 288, 0, 256, 1024, attn_norm, WB + WO_MIX, 0, 0) CJ(wq_a, 384, 0, 384, 1024, attn_norm, WB + WO_MIX, 256, 0) CJ(wkv_a, 288, 256, 32, 1024, attn_norm, WB + WO_MIX, 640, 3)
            CJ(wq_b, 1536, 0, 1536, 384, q_norm, WB + WO_QB, 0, 2) CJ(wkv_b, 2048, 0, 2048, 256, kv_norm, WB + WO_KVB, 0, 0) }
    } else if (kind == 1) {
        const float* w_qkv = ldarg(13); const float* w_f = ldarg(14);
        zero_rows(WB + WO_MIX + (size_t)3088 * 1024, (size_t)240 * 1024, gt, NGT);
        for (int it = gw; it < 2048 + 2048 + 512 + 1536 + 16; it += NGW) { int r_ = it;
            CJ_MLP
            CJ(w_qkv, 3072, 0, 3072, 1024, attn_norm, WB + WO_MIX, 0, 0) CJ(w_f, 16, 0, 16, 1024, attn_norm, WB + WO_MIX, 3072, 0) }
    } else {
        const float* w_qkv = ldarg(21);
        for (int it = gw; it < 2048 + 2048 + 512 + 4608; it += NGW) { int r_ = it;
            CJ_MLP
            CJ(w_qkv, 9216, 0, 9216, 1024, attn_norm, WB + WO_MIX, 0, 1) }
    }
#undef CJ
#undef CJ_MLP
}
struct Params { const float* in[38]; float* out; unsigned char* ws; int lo, hi; };

__global__ void __launch_bounds__(512) mega(Params P) {
    extern __shared__ __attribute__((aligned(16))) unsigned char lds_raw[];
    LAS unsigned char* lds = (LAS unsigned char*)lds_raw;
    cg::grid_group grid = cg::this_grid();
    { volatile LAS unsigned* st_ = (volatile LAS unsigned*)(lds + LDS_BYTES - 64); if (threadIdx.x < 2) st_[threadIdx.x] = 0u; }
    __syncthreads();
    XcdBarrier xbar; xbar.bar = (unsigned*)P.ws; xbar.x = 0; xbar.st = (volatile LAS unsigned*)(lds + LDS_BYTES - 64);
    const int G = gridDim.x, NGW = G * 8, NGT = G * 512;
#define IDS const int tid = otid(), lane = tid & 63, wave = __builtin_amdgcn_readfirstlane(tid >> 6), bx = obid(), gw = bx * 8 + wave, gt = bx * 512 + tid; LAS float* scr = (LAS float*)(lds + wave * 16384); (void)lane; (void)gw; (void)gt; (void)scr; \
    unsigned char* ws = P.ws; asm volatile("" : "+s"(ws)); float* H = P.out; asm volatile("" : "+s"(H)); bf16_t* HL = (bf16_t*)H; (void)HL; \
    float* cosM = (float*)(ws + WS_COSM); float* sinM = (float*)(ws + WS_SINM); float* cosD = (float*)(ws + WS_COSD); float* sinD = (float*)(ws + WS_SIND); \
    u64* SSA = (u64*)(ws + WS_P16); u64* SSB = SSA + T_TOK; u64* SQ = SSB + T_TOK; u64* SKV = SQ + T_TOK; \
    bf16_t* WB0 = (bf16_t*)(ws + WS_W); bf16_t* WB1 = (bf16_t*)(ws + WS_W1); bf16_t* HB = (bf16_t*)(ws + WS_HB); unsigned char* R = ws + WS_R; \
    float* LOGF = (float*)(ws + WS_LOGF); float* DLB = (float*)(ws + WS_DL); bf16_t* KPE = (bf16_t*)(ws + WS_KPE); float* LSE = (float*)(ws + WS_LSE); \
    (void)H; (void)cosM; (void)sinM; (void)cosD; (void)sinD; (void)SSA; (void)SSB; (void)SQ; (void)SKV; (void)WB0; (void)WB1; (void)HB; (void)R; (void)LOGF; (void)DLB; (void)KPE; (void)LSE
    const int lo = P.lo, hi = P.hi;
    int ph = 0;
#define PH_ON (ph >= lo && ph < hi)
#define PH_END do { if (ph >= lo && ph + 1 < hi) { if (ph == 0) { grid.sync(); xbar = xcd_barrier_post((unsigned*)P.ws, (volatile LAS unsigned*)(lds + LDS_BYTES - 64)); } else xcd_barrier(xbar); } ++ph; } while (0)

    if (PH_ON) { IDS;
        if (bx == 0) for (int i = tid; i < 4096; i += 512) __hip_atomic_store((unsigned*)ws + i, 0u, __ATOMIC_RELAXED, __HIP_MEMORY_SCOPE_AGENT);
        for (int i = gt; i < SEQ * 16; i += NGT) { const int pos = i >> 4, f = i & 15; float s, c; sincos_acc((float)pos * INV16[f], s, c); *(GAS float*)(cosM + i) = c; *(GAS float*)(sinM + i) = s; }
        for (int i = gt; i < SEQ * 32; i += NGT) { const int pos = i >> 5, f = i & 31; float s, c; sincos_acc((float)pos * INV32[f], s, c); *(GAS float*)(cosD + i) = c; *(GAS float*)(sinD + i) = s; }
        const float* x = ldarg(0);
        for (int row = gw; row < T_TOK; row += NGW) {
            const GAS f32x4* xr = (const GAS f32x4*)(x + (size_t)row * DM) + lane; float ss = 0.f;
#pragma unroll
            for (int j = 0; j < 4; ++j) { const f32x4 v = xr[64 * j]; ss += dot4(v); u32x2 hh_, ll_; { const u32x2 s0 = split2(v.x, v.y), s1 = split2(v.z, v.w); hh_.x = s0.x; ll_.x = s0.y; hh_.y = s1.x; ll_.y = s1.y; }
                *(GAS u32x2*)(HB + (size_t)row * DM + 4 * lane + 256 * j) = hh_; if (RES_LO) *(GAS u32x2*)(HL + (size_t)row * DM + 4 * lane + 256 * j) = ll_; }
            ss = wave_sum(ss);
            if (lane == 0) { st_dev(SSB + row, ss); st_dev(SSA + row, 0.f); }
        }
        cvt_layer(0, WB0, SQ, SKV, scr, gw, NGW, gt, NGT, lane);
    }
    PH_END;

#pragma nounroll
    for (int layer = 0; layer < 4; ++layer) {
        const int kind = (layer == 3) ? 0 : layer;
#define WB ((layer & 1) ? WB1 : WB0)
#define Obuf ((bf16_t*)(R + (kind == 0 ? R_O_MLA : kind == 1 ? R_O_FOX : R_O_DIL)))
        if (kind == 0) {
#define CKV ((bf16_t*)(R + R_CKV))
#define CQ ((bf16_t*)(R + R_CQ))
#define Q ((bf16_t*)(R + R_Q))
#define KV ((bf16_t*)(R + R_KV))
            if (PH_ON) { IDS;
                pg8::Gemm g{HB, WB + WO_MIX, T_TOK, 768, 1024}; pg8::StaticOrder S; S.init(T_TOK, 768, G, bx);
                EpiMlaA E{SSB, CKV, CQ, KPE, SQ, SKV, cosM, sinM};
                pg8::gemm_phase<EpiMlaA, pg8::StaticOrder, true, true>(lds, g, S, E);
            }
            PH_END;
            if (PH_ON) { IDS;
                { pg8::Gemm g{CQ, WB + WO_QB, T_TOK, 1536, 384}; pg8::StaticOrder S; S.init(T_TOK, 1536, G, bx);
                  EpiMlaQ E{SQ, Q, cosM, sinM};
                  pg8::gemm_phase<EpiMlaQ, pg8::StaticOrder, true, true>(lds, g, S, E); }
                __syncthreads();
                { pg8::Gemm g{CKV, WB + WO_KVB, T_TOK, 2048, 256}; pg8::StaticOrder S; S.init(T_TOK, 2048, G, bx);
                  EpiMlaKV E{SKV, KV};
                  pg8::gemm_phase<EpiMlaKV, pg8::StaticOrder, true, true>(lds, g, S, E); }
            }
            PH_END;
            if (PH_ON) { IDS;
                u32x4 kreg0 = {0, 0, 0, 0}, kreg1 = kreg0, k2reg = kreg0, vreg0 = kreg0, vreg1 = kreg0; f32x4 dkreg = {0.f, 0.f, 0.f, 0.f}; bool pre = false;
                for (int L = bx; L < 2048; L += G) {
                    const int slot = 7 - (L >> 8), v = L & 255, bh = ((v >> 4) << 3) | (v & 7), p = (v >> 3) & 1, b = bh >> 4, hh = bh & 15;
                    const int base = 4 * (slot >> 1), qb = (slot & 1) ? base + 3 - p : base + p;
                    const size_t t0 = (size_t)b * SEQ;
                    const int Ln = L + G; const bool has_next = Ln < 2048;
                    const int vn = Ln & 255, bhn = ((vn >> 4) << 3) | (vn & 7); const size_t t0n = (size_t)(bhn >> 4) * SEQ; const int hn = bhn & 15;
                    attn_unit<96, 0>(lds, Q + t0 * 1536 + hh * 96, 1536, KV + t0 * 2048 + hh * 128, 2048, KPE + t0 * 32, 32,
                                     KV + t0 * 2048 + hh * 128 + 64, 2048, Obuf + t0 * 1024 + hh * 64, 1024, nullptr, nullptr, 0, qb * 256, 1 << 20,
                                     pre, has_next, KV + t0n * 2048 + hn * 128, KPE + t0n * 32, KV + t0n * 2048 + hn * 128 + 64, nullptr, kreg0, kreg1, k2reg, vreg0, vreg1, dkreg);
                    pre = has_next;
                }
            }
            PH_END;
        } else if (kind == 1) {
#define QKV ((bf16_t*)(R + R_QKV))
            if (PH_ON) { IDS;
                pg8::Gemm g{HB, WB + WO_MIX, T_TOK, 3328, 1024}; pg8::StaticOrder S; S.init(T_TOK, 3328, G, bx);
                EpiFox E{SSB, QKV, LOGF, ldarg(15)};
                pg8::gemm_phase<EpiFox, pg8::StaticOrder, true, true>(lds, g, S, E);
            }
            PH_END;
            if (PH_ON) { IDS;
                for (int sq = gw; sq < 128; sq += NGW) {
                    const float* src = LOGF + (size_t)(sq >> 4) * SEQ * 16 + (sq & 15) + (size_t)(64 * lane) * 16;
                    float s = 0.f;
                    float lv[64];
#pragma unroll
                    for (int i = 0; i < 64; ++i) lv[i] = *(const GAS float*)(src + i * 16);
#pragma unroll
                    for (int i = 0; i < 64; ++i) s += lv[i];
                    float inc = s;
#pragma unroll
                    for (int o = 1; o < 64; o <<= 1) { const float t = __shfl_up(inc, o); if (lane >= o) inc += t; }
                    float run = inc - s; float* dst = DLB + (size_t)sq * SEQ + 64 * lane;
#pragma unroll
                    for (int i = 0; i < 64; ++i) { run += lv[i]; *(GAS float*)(dst + i) = run * LOG2E; }
                }
            }
            PH_END;
            if (PH_ON) { IDS;
                u32x4 kreg0 = {0, 0, 0, 0}, kreg1 = kreg0, k2reg = kreg0, vreg0 = kreg0, vreg1 = kreg0; f32x4 dkreg = {0.f, 0.f, 0.f, 0.f}; bool pre = false;
                for (int L = bx; L < 2048; L += G) {
                    const int slot = 7 - (L >> 8), v = L & 255, bh = ((v >> 4) << 3) | (v & 7), p = (v >> 3) & 1, b = bh >> 4, hh = bh & 15;
                    const int base = 4 * (slot >> 1), qb = (slot & 1) ? base + 3 - p : base + p;
                    const size_t t0 = (size_t)b * SEQ;
                    const int Ln = L + G; const bool has_next = Ln < 2048;
                    const int vn = Ln & 255, bhn = ((vn >> 4) << 3) | (vn & 7); const size_t t0n = (size_t)(bhn >> 4) * SEQ; const int hn = bhn & 15;
                    attn_unit<64, 1>(lds, QKV + t0 * 3072 + hh * 64, 3072, QKV + t0 * 3072 + 1024 + hh * 64, 3072, nullptr, 0,
                                     QKV + t0 * 3072 + 2048 + hh * 64, 3072, Obuf + t0 * 1024 + hh * 64, 1024, DLB + (size_t)bh * SEQ, nullptr, 0, qb * 256, 1 << 20,
                                     pre, has_next, QKV + t0n * 3072 + 1024 + hn * 64, nullptr, QKV + t0n * 3072 + 2048 + hn * 64, DLB + (size_t)bhn * SEQ, kreg0, kreg1, k2reg, vreg0, vreg1, dkreg);
                    pre = has_next;
                }
            }
            PH_END;
        } else {
#define QKVC ((bf16_t*)(R + R_QKV))
#pragma nounroll
            for (int ch = 0; ch < 2; ++ch) {
                const size_t row0 = (size_t)ch * 16384;
                if (PH_ON) { IDS;
                    pg8::Gemm g{HB + row0 * DM, WB + WO_MIX, 16384, 9216, 1024}; pg8::StaticOrder S; S.init(16384, 9216, G, bx);
                    EpiDil E{SSB + row0, QKVC, cosD, sinD};
                    pg8::gemm_phase<EpiDil, pg8::StaticOrder, true, true>(lds, g, S, E);
                }
                PH_END;
                if (PH_ON) { IDS;
                    dil_phase(lds, QKVC, LSE, bx, G);
                }
                PH_END;
                if (PH_ON) { IDS;
                    for (int i = gt; i < 16384 * 128; i += NGT) {
                        const int tok = i >> 7, c8 = i & 127, hd = c8 >> 3;
                        const GAS float* lp = (const GAS float*)(LSE + (size_t)tok * 48 + hd); const float l0 = lp[0], l1 = lp[16], l2 = lp[32];
                        const float mx = fmaxf(l0, fmaxf(l1, l2));
                        float w0 = __builtin_amdgcn_exp2f(l0 - mx), w1 = __builtin_amdgcn_exp2f(l1 - mx), w2 = __builtin_amdgcn_exp2f(l2 - mx);
                        const float iw = 1.f / (w0 + w1 + w2); w0 *= iw; w1 *= iw; w2 *= iw;
                        const int cbl = tok >> 12, ct = tok & 4095, cch = c8 & 7;
                        const size_t r0 = ct, r1 = ((size_t)(ct & 3) << 10) + (ct >> 2), r2 = ((size_t)(ct & 15) << 8) + (ct >> 4);
                        const bf16_t* pl = QKVC + (size_t)((cbl * 9) * 16 + hd) * 4096 * 64 + cch * 8;
                        const u32x4 a = *(const GAS u32x4*)(pl + r0 * 64), b = *(const GAS u32x4*)(pl + ((size_t)16 * 4096 + r1) * 64), c = *(const GAS u32x4*)(pl + ((size_t)32 * 4096 + r2) * 64);
                        u32x4 o;
#pragma unroll
                        for (int e = 0; e < 4; ++e) {
                            const float alo = __uint_as_float(a[e] << 16), ahi = __uint_as_float(a[e] & 0xffff0000u);
                            const float blo = __uint_as_float(b[e] << 16), bhi = __uint_as_float(b[e] & 0xffff0000u);
                            const float clo = __uint_as_float(c[e] << 16), chi = __uint_as_float(c[e] & 0xffff0000u);
                            o[e] = cvtpk(w0 * alo + w1 * blo + w2 * clo, w0 * ahi + w1 * bhi + w2 * chi);
                        }
                        *(GAS u32x4*)(Obuf + (row0 + tok) * 1024 + c8 * 8) = o;
                    }
                }
                PH_END;
            }
        }
        if (PH_ON) { IDS;
            pg8::Gemm g{Obuf, WB + WO_WO, T_TOK, 1024, 1024}; pg8::StaticOrder S; S.init(T_TOK, 1024, G, bx);
            for (int i = gt; i < T_TOK; i += NGT) st_dev(SSB + i, 0.f);
            EpiRes E{HB, HL, HL, SSA};
            pg8::gemm_phase<EpiRes, pg8::StaticOrder, true, true>(lds, g, S, E);
        }
        PH_END;
        if (PH_ON) { IDS;
            pg8::Gemm g{HB, WB + WO_UP, T_TOK, 4096, 1024}; pg8::StaticOrder S; S.init(T_TOK, 4096, G, bx);
            EpiUp E{SSA, (bf16_t*)(R + R_U)};
            pg8::gemm_phase<EpiUp, pg8::StaticOrder, true, true>(lds, g, S, E);
        }
        PH_END;
        if (PH_ON) { IDS;
            pg8::Gemm g{(const bf16_t*)(R + R_U), WB + WO_DOWN, T_TOK, 1024, 4096}; pg8::StaticOrder S; S.init(T_TOK, 1024, G, bx);
            for (int i = gt; i < T_TOK; i += NGT) st_dev(SSA + i, 0.f);
            if (layer < 3) { cvt_layer(layer + 1, (layer & 1) ? WB0 : WB1, SQ, SKV, scr, gw, NGW, gt, NGT, lane); __syncthreads(); }
            EpiRes E{HB, HL, (layer == 3) ? (bf16_t*)(R + 256 * MiB) : HL, SSB};
            pg8::gemm_phase<EpiRes, pg8::StaticOrder, true, true>(lds, g, S, E);
        }
        PH_END;
    }
    if (PH_ON) { IDS;
        const float* gain = ldarg(37);
        for (int row = gw; row < T_TOK; row += NGW) {
            const float rs = rsqrtf(ld_dev(SSB + row) * (1.f / 1024.f) + EPS);
            const GAS u32x2* hp = (const GAS u32x2*)(HB + (size_t)row * DM) + lane; const GAS u32x2* lp = (const GAS u32x2*)((const bf16_t*)(R + 256 * MiB) + (size_t)row * DM) + lane;
            GAS f32x4* orow = (GAS f32x4*)(H + (size_t)row * DM) + lane; const GAS f32x4* gr = (const GAS f32x4*)gain + lane;
#pragma unroll
            for (int j = 0; j < 4; ++j) { const u32x2 hh_ = hp[64 * j], ll_ = RES_LO ? lp[64 * j] : (u32x2){0u, 0u}; const f32x4 gq = gr[64 * j];
                f32x4 v = {bflo(hh_.x) + bflo(ll_.x), bfhi(hh_.x) + bfhi(ll_.x), bflo(hh_.y) + bflo(ll_.y), bfhi(hh_.y) + bfhi(ll_.y)};
                orow[64 * j] = v * rs * gq; }
        }
    }
    PH_END;
#undef PH_ON
#undef PH_END
}

constexpr int N_PHASES = 1 + 6 + 6 + 9 + 6 + 1;
#ifndef MK_COOP
#define MK_COOP 1
#endif

extern "C" void kernel_launch(void* const* d_in, const int* in_sizes, int n_in, void* d_out, int out_size, void* d_ws, size_t ws_size, hipStream_t stream) {
    static int grid = 0;
    if (grid == 0) {
        if (n_in != 38 || out_size != T_TOK * DM || ws_size < WS_NEED) { fprintf(stderr, "kernel_launch: unexpected shapes (n_in %d out %d ws %zu)\n", n_in, out_size, ws_size); grid = -1; return; }
        int dev = 0, cus = 0, per_cu = 0;
        hipGetDevice(&dev); hipDeviceGetAttribute(&cus, hipDeviceAttributeMultiprocessorCount, dev);
        if (hipFuncSetAttribute((const void*)mega, hipFuncAttributeMaxDynamicSharedMemorySize, LDS_BYTES) != hipSuccess) { fprintf(stderr, "kernel_launch: hipFuncSetAttribute failed\n"); grid = -1; return; }
        if (hipOccupancyMaxActiveBlocksPerMultiprocessor(&per_cu, (const void*)mega, 512, LDS_BYTES) != hipSuccess || per_cu < 1) per_cu = 1;
        (void)hipGetLastError();
        grid = cus * per_cu;
        if (grid <= 0) grid = 256;
    }
    if (grid < 0) return;
    Params p{};
    for (int i = 0; i < 38; ++i) p.in[i] = (const float*)d_in[i];
    p.out = (float*)d_out; p.ws = (unsigned char*)d_ws;
#if MK_COOP
    p.lo = 0; p.hi = N_PHASES;
    void* args[] = {&p};
    hipError_t e = hipLaunchCooperativeKernel((const void*)mega, dim3(grid), dim3(512), args, LDS_BYTES, stream);
    if (e != hipSuccess) fprintf(stderr, "cooperative launch failed: %s (grid %d)\n", hipGetErrorString(e), grid);
#else
    for (int k = 0; k < N_PHASES; ++k) { p.lo = k; p.hi = k + 1; hipLaunchKernelGGL(mega, dim3(grid), dim3(512), LDS_BYTES, stream, p); }
#endif
}
```
